# Optimizing an MI355X kernel written in HIP

```python
import jax, jax.numpy as jnp
from jax import lax
import numpy as np

D_MODEL = 2048
BATCH = 8
SEQ = 2048
DEPTH = 1

D_MIX = D_MODEL
A_HEADS = 8
A_HEAD_DIM = D_MIX // 2 // A_HEADS
A_WIDTH = A_HEADS * A_HEAD_DIM
CHUNK = 128
B_GROUPS = 8
B_WIDTH = D_MIX - A_WIDTH
CONV_W = 3
IN_COLS = 2 * A_WIDTH + 3 * B_WIDTH
N_GROUPS = 4
EXPERTS_PER_GROUP = 8
N_EXPERTS = N_GROUPS * EXPERTS_PER_GROUP
TOP_K = 2
D_EXPERT = D_MODEL // 4
MOE_BLOCK = 128
N_MOD = 6
EPS = 1e-6

kernel_name = "hybrid_gmlp_shortconv_hmoe_adaln"


def rms_norm(x, g):
    xf = x.astype(jnp.float32)
    y = xf * lax.rsqrt(jnp.mean(xf * xf, axis=-1, keepdims=True) + EPS)
    return (y * g.astype(jnp.float32)).astype(x.dtype)


def modulate(h, shift, scale):
    return h * (1 + scale[:, None, :]) + shift[:, None, :]


def gmlp_chunk_mixer(z, w_s, b_s, v_gain):
    bsz, s, _ = z.shape
    u, v = jnp.split(z, 2, axis=-1)
    v = v.reshape(bsz, s // CHUNK, CHUNK, A_HEADS, A_HEAD_DIM)
    v = rms_norm(v, v_gain)
    mask = jnp.tril(jnp.ones((CHUNK, CHUNK), dtype=bool))
    w = jnp.where(mask[None], w_s, jnp.zeros_like(w_s))
    zs = jnp.einsum('htq,bcqhd->bcthd', w, v) + b_s.T[None, None, :, :, None]
    return u * zs.reshape(bsz, s, A_WIDTH)


def short_conv_mixer(z, conv_w, conv_b):
    s = z.shape[1]
    bg, cg, xin = jnp.split(z, 3, axis=-1)
    pre = cg * xin
    p = jnp.pad(pre, ((0, 0), (CONV_W - 1, 0), (0, 0)))
    conv = conv_w[0] * p[:, 0:s]
    for k in range(1, CONV_W):
        conv = conv + conv_w[k] * p[:, k:k + s]
    return bg * (conv + conv_b)


def hier_moe(h, w_router_group, b_router_group, w_router_expert, b_router_expert, w_gate_up, w_down):
    bsz, s, d = h.shape
    t = bsz * s
    xt = h.reshape(t, d)
    xf = xt.astype(jnp.float32)
    g_logits = xf @ w_router_group.astype(jnp.float32) + b_router_group.astype(jnp.float32)
    g_prob = jax.nn.softmax(g_logits, axis=-1)
    grp = jnp.argmax(g_logits, axis=-1)
    p_grp = jnp.take_along_axis(g_prob, grp[:, None], axis=-1)
    e_logits = (xf @ w_router_expert.astype(jnp.float32) + b_router_expert.astype(jnp.float32))
    e_logits = e_logits.reshape(t, N_GROUPS, EXPERTS_PER_GROUP)
    e_logits_g = jnp.take_along_axis(e_logits, grp[:, None, None], axis=1)[:, 0]
    top_val, top_idx = lax.top_k(e_logits_g, TOP_K)
    gates = p_grp * jax.nn.softmax(top_val, axis=-1)
    expert_id = grp[:, None] * EXPERTS_PER_GROUP + top_idx
    n_assign = t * TOP_K
    flat_e = expert_id.reshape(-1).astype(jnp.int32)
    flat_tok = jnp.repeat(jnp.arange(t, dtype=jnp.int32), TOP_K)
    flat_gate = gates.reshape(-1)
    order = jnp.argsort(flat_e)
    se = flat_e[order]
    counts = jnp.bincount(flat_e, length=N_EXPERTS)
    padded = ((counts + MOE_BLOCK - 1) // MOE_BLOCK) * MOE_BLOCK
    starts = jnp.cumsum(counts) - counts
    pends = jnp.cumsum(padded)
    pstarts = pends - padded
    dest = pstarts[se] + (jnp.arange(n_assign, dtype=jnp.int32) - starts[se])
    n_pad = n_assign + N_EXPERTS * MOE_BLOCK
    n_blocks = n_pad // MOE_BLOCK
    buf_tok = jnp.zeros((n_pad,), jnp.int32).at[dest].set(flat_tok[order])
    buf_gate = jnp.zeros((n_pad,), jnp.float32).at[dest].set(flat_gate[order])
    block_expert = jnp.minimum(
        jnp.searchsorted(pends, jnp.arange(n_blocks, dtype=jnp.int32) * MOE_BLOCK, side='right'),
        N_EXPERTS - 1).astype(jnp.int32)
    xb = xt[buf_tok].reshape(n_blocks, MOE_BLOCK, d)

    def expert_block(args):
        xblk, e = args
        gu = xblk @ w_gate_up[e]
        g, u = jnp.split(gu, 2, axis=-1)
        return (jax.nn.silu(g) * u) @ w_down[e]

    yb = lax.map(expert_block, (xb, block_expert))
    y = yb.reshape(n_pad, d) * buf_gate[:, None].astype(h.dtype)
    out = jnp.zeros((t, d), h.dtype).at[buf_tok].add(y)
    return out.reshape(bsz, s, d)


def setup_inputs(seed: int = 0) -> dict:
    key = jax.random.key(seed)
    ks = jax.random.split(key, 24)
    f32 = jnp.float32
    nrm = lambda k, shape, sc: jax.random.normal(k, shape, f32) * sc
    L = DEPTH
    return {
        "x": jax.random.normal(ks[0], (BATCH, SEQ, D_MODEL), f32),
        "c": jax.random.normal(ks[1], (BATCH, D_MODEL), f32),
        "w_ada": nrm(ks[2], (L, D_MODEL, N_MOD * D_MODEL), 0.5 * D_MODEL ** -0.5),
        "b_ada": nrm(ks[3], (L, N_MOD * D_MODEL), 0.02),
        "norm1_g": 1.0 + nrm(ks[4], (L, D_MODEL), 0.02),
        "w_in": nrm(ks[5], (L, D_MODEL, IN_COLS), D_MODEL ** -0.5),
        "w_out": nrm(ks[6], (L, D_MIX, D_MODEL), D_MIX ** -0.5),
        "gmlp_w_s": nrm(ks[7], (L, A_HEADS, CHUNK, CHUNK), CHUNK ** -0.5),
        "gmlp_b_s": 1.0 + nrm(ks[8], (L, A_HEADS, CHUNK), 0.02),
        "gmlp_v_gain": 1.0 + nrm(ks[9], (L, A_HEADS, A_HEAD_DIM), 0.02),
        "conv_w": nrm(ks[10], (L, CONV_W, B_WIDTH), CONV_W ** -0.5),
        "conv_b": nrm(ks[11], (L, B_WIDTH), 0.02),
        "norm2_g": 1.0 + nrm(ks[12], (L, D_MODEL), 0.02),
        "w_router_group": nrm(ks[13], (L, D_MODEL, N_GROUPS), D_MODEL ** -0.5),
        "b_router_group": nrm(ks[14], (L, N_GROUPS), 0.01),
        "w_router_expert": nrm(ks[15], (L, D_MODEL, N_EXPERTS), D_MODEL ** -0.5),
        "b_router_expert": nrm(ks[16], (L, N_EXPERTS), 0.01),
        "w_gate_up": nrm(ks[17], (L, N_EXPERTS, D_MODEL, 2 * D_EXPERT), D_MODEL ** -0.5),
        "w_down": nrm(ks[18], (L, N_EXPERTS, D_EXPERT, D_MODEL), D_EXPERT ** -0.5),
        "w_ada_final": nrm(ks[19], (D_MODEL, 2 * D_MODEL), 0.5 * D_MODEL ** -0.5),
        "b_ada_final": nrm(ks[20], (2 * D_MODEL,), 0.02),
        "norm_f_g": 1.0 + nrm(ks[21], (D_MODEL,), 0.02),
    }


def reference(x, c, w_ada, b_ada, norm1_g, w_in, w_out, gmlp_w_s, gmlp_b_s, gmlp_v_gain,
              conv_w, conv_b, norm2_g, w_router_group, b_router_group, w_router_expert,
              b_router_expert, w_gate_up, w_down, w_ada_final, b_ada_final, norm_f_g):
    c_act = jax.nn.silu(c)
    for l in range(DEPTH):
        mod = c_act @ w_ada[l] + b_ada[l]
        shift1, scale1, gate1, shift2, scale2, gate2 = jnp.split(mod, N_MOD, axis=-1)
        h = modulate(rms_norm(x, norm1_g[l]), shift1, scale1)
        proj = h @ w_in[l]
        y_a = gmlp_chunk_mixer(jax.nn.gelu(proj[..., :2 * A_WIDTH]),
                               gmlp_w_s[l], gmlp_b_s[l], gmlp_v_gain[l])
        y_b = short_conv_mixer(proj[..., 2 * A_WIDTH:], conv_w[l], conv_b[l])
        mix = jnp.concatenate([y_a, y_b], axis=-1) @ w_out[l]
        x = x + gate1[:, None, :] * mix
        h = modulate(rms_norm(x, norm2_g[l]), shift2, scale2)
        ffn = hier_moe(h, w_router_group[l], b_router_group[l], w_router_expert[l],
                       b_router_expert[l], w_gate_up[l], w_down[l])
        x = x + gate2[:, None, :] * ffn
    shift_f, scale_f = jnp.split(c_act @ w_ada_final + b_ada_final, 2, axis=-1)
    return modulate(rms_norm(x, norm_f_g), shift_f, scale_f)
```

```cpp
#include <hip/hip_runtime.h>
#include <cstdio>
#include <cstdint>

#ifndef MK_N_LAUNCHES
#define MK_N_LAUNCHES 1
#endif

#define GAS __attribute__((address_space(1)))
#define LAS __attribute__((address_space(3)))
typedef _Float16 h16;
typedef _Float16 h16x8 __attribute__((ext_vector_type(8)));
typedef _Float16 h16x4 __attribute__((ext_vector_type(4)));
typedef _Float16 h16x2 __attribute__((ext_vector_type(2)));
typedef float f32x4 __attribute__((ext_vector_type(4)));
typedef float f32x2 __attribute__((ext_vector_type(2)));
typedef unsigned u32x4 __attribute__((ext_vector_type(4)));
typedef unsigned u32x2 __attribute__((ext_vector_type(2)));

constexpr int NB = 8, SEQ = 2048, D = 2048, T = NB * SEQ;
constexpr int INC = 5120, AW = 1024, NE = 32, DE = 512, GU = 1024, NMOD = 6 * D, NMODF = 2 * D;
constexpr int NRP = 48;
constexpr float EPS = 1e-6f;
constexpr int MAXTILES = 160, MAXU = 8;
constexpr int NPHASE = 9;

constexpr size_t MiB = 1u << 20;
constexpr size_t WS_CTL = 0, CTL_ZERO_BYTES = 1 * MiB;
constexpr size_t WS_MOD = 1 * MiB, WS_MODF = 1 * MiB + 512 * 1024, WS_SW = 1 * MiB + 768 * 1024;
constexpr size_t WS_WRH = 2 * MiB, WS_WRL = 2 * MiB + 256 * 1024;
constexpr size_t WS_LCODE = 3 * MiB, WS_LGATE = 5 * MiB;
constexpr size_t WS_WIN = 8 * MiB, WS_WOUT = 28 * MiB, WS_WGU = 36 * MiB, WS_WD = 164 * MiB;
constexpr size_t WS_H = 228 * MiB, WS_PROJ = 292 * MiB, WS_Y = 452 * MiB, WS_ACT = 516 * MiB, WS_YB = WS_PROJ, WS_END = 556 * MiB;
constexpr int CW_BAR = 4096, CW_CNT = 16384;

constexpr int RING_BYTES = 131072, MISC_OFF = RING_BYTES + 320, TAB_OFF = RING_BYTES + 1024, ROWT_OFF = TAB_OFF + 512, GATET_OFF = ROWT_OFF + MAXU * 256 * 4;
constexpr int LDS_BYTES = GATET_OFF + MAXU * 256 * 4;
static_assert(LDS_BYTES <= 160 * 1024, "LDS");

__device__ __forceinline__ unsigned pkh(float a, float b) { f32x2 v = {a, b}; h16x2 h = __builtin_convertvector(v, h16x2); return __builtin_bit_cast(unsigned, h); }
__device__ __forceinline__ float gelu_t(float x) {
    const float u = x * (0.7978845608f + 0.0356774081f * x * x);
    return x * __builtin_amdgcn_rcpf(1.0f + __builtin_amdgcn_exp2f(-2.8853900818f * u));
}
__device__ __forceinline__ float silu_f(float x) { return x * __builtin_amdgcn_rcpf(1.0f + __builtin_amdgcn_exp2f(-1.4426950409f * x)); }
__device__ __forceinline__ float wave_sum(float v) {
#pragma unroll
    for (int o = 1; o < 64; o <<= 1) v += __shfl_xor(v, o);
    return v;
}

namespace pg8 {
constexpr int BM = 256, BK = 64, HALF = 128, HTB = HALF * BK * 2, STAGE_BYTES = 8 * HTB, NXCD = 8, WGM = 8;
__host__ __device__ __forceinline__ int lds_byte(int r, int c) { const int st = (r >> 4) * 2 + (c >> 5), rr = r & 15, cc = c & 31, ob = rr * 64 + cc * 2; return st * 1024 + (ob ^ (((ob >> 9) & 1) << 5)); }
__host__ __device__ __forceinline__ void stage_rc(int b, int& R, int& C) { const int st = b / 1024, sb = b % 1024, swz = sb ^ (((sb >> 9) & 1) << 5); R = (st >> 1) * 16 + swz / 64; C = (st & 1) * 32 + (swz % 64) / 2; }
__host__ __device__ __forceinline__ int perm32(int rho) { const int n = rho >> 4, i = rho & 15; return 8 * (i >> 2) + 4 * n + (i & 3); }

struct Unit { const char* A; const char* B; int pm, pn, idx, e, nvalid; };

__device__ __forceinline__ int xcd_remap(int L, int nwg) { const int q = nwg / NXCD, r = nwg % NXCD, xcd = L % NXCD, off = L / NXCD; return (xcd < r ? xcd * (q + 1) : r * (q + 1) + (xcd - r) * q) + off; }

struct DenseOrder {
    const char* A; const char* Bt; size_t tstep; int nM, nN, nwg, G, c;
    __device__ void init(const void* A_, const void* Bt_, int M, int N, int K, int G_, int c_) { A = (const char*)A_; Bt = (const char*)Bt_; tstep = (size_t)BM * K * 2; nM = M / BM; nN = N / BM; nwg = nM * nN; G = G_; c = c_; }
    __device__ __forceinline__ bool next(int i, Unit& u) const {
        const long L = (long)i * G + c; if (L >= nwg) return false;
        const int wgid = xcd_remap((int)L, nwg);
        const int nig = WGM * nN, gid = wgid / nig, fm = gid * WGM, gsz = (nM - fm) < WGM ? (nM - fm) : WGM;
        u.pm = fm + ((wgid % nig) % gsz); u.pn = (wgid % nig) / gsz; u.idx = i; u.e = 0; u.nvalid = BM;
        u.A = A + (size_t)u.pm * tstep; u.B = Bt + (size_t)u.pn * tstep; return true;
    }
};
struct MoeOrder {
    const char* A; const char* Bt; size_t a_tile, b_exp, b_pn; int NT, nwg, G, c; const LAS int* tab;
    __device__ __forceinline__ bool next(int i, Unit& u) const {
        const long L = (long)i * G + c; if (L >= nwg) return false;
        const int wgid = xcd_remap((int)L, nwg);
        const int tile = wgid / NT, pn = wgid % NT;
        int e = 0;
#pragma unroll
        for (int j = 1; j < NE; ++j) e += (tab[32 + j] <= tile) ? 1 : 0;
        e = __builtin_amdgcn_readfirstlane(e);
        const int mt = tile - __builtin_amdgcn_readfirstlane(tab[32 + e]);
        int nv = __builtin_amdgcn_readfirstlane(tab[e]) - mt * BM; nv = nv > BM ? BM : nv;
        u.pm = tile; u.pn = pn; u.idx = i; u.e = e; u.nvalid = nv;
        u.A = A + (size_t)tile * a_tile; u.B = Bt + (size_t)e * b_exp + (size_t)pn * b_pn; return true;
    }
};

template <class Epi, class Sched, bool GATHER>
__device__ __forceinline__ void gemm_phase(LAS unsigned char* lds, const int K, const Sched& S, const Epi& E, const LAS unsigned* rowtab) {
    const int tid = threadIdx.x, wid = __builtin_amdgcn_readfirstlane(tid >> 6), lane = tid & 63, wr = wid >> 2, wc = wid & 3, fr = lane & 15, fq = lane >> 4;
    const int nt = K / BK;
    unsigned voffA[2], voffB[2]; int RA[2]; unsigned CA2[2];
#pragma unroll
    for (int i = 0; i < 2; ++i) { int R, C; stage_rc(tid * 16 + i * 8192, R, C); const int Rb = Epi::PERM ? ((R & ~31) + perm32(R & 31)) : R;
        voffA[i] = (unsigned)(R * K + C) * 2u; voffB[i] = (unsigned)(Rb * K + C) * 2u; RA[i] = R; CA2[i] = (unsigned)C * 2u; }
    const size_t kstep = (size_t)(BK * 2);
    const size_t hstep = (size_t)HALF * K * 2;
    const unsigned ldsw = (unsigned)wid * 1024u;
    const int aoff = lds_byte(wr * 64 + fr, fq * 8), boff = lds_byte(wc * 32 + fr, fq * 8);
    unsigned vAc[2][2], vAn[2][2];
#define PG8_SA(b, h) (((b) * 2 + (h)) * HTB)
#define PG8_SB(b, h) ((4 + (b) * 2 + (h)) * HTB)
#define PG8_STAGE2(bufoff, gbase, o0, o1) do { \
        __builtin_amdgcn_global_load_lds((const unsigned*)((const char*)(gbase) + (o0)), (LAS unsigned*)(lds + (bufoff) + ldsw), 16, 0, 0); \
        __builtin_amdgcn_global_load_lds((const unsigned*)((const char*)(gbase) + (o1)), (LAS unsigned*)(lds + (bufoff) + ldsw + 8192), 16, 0, 0); } while (0)
#define PG8_STAGE_B(bufoff, bptr) PG8_STAGE2(bufoff, bptr, voffB[0], voffB[1])
#define PG8_STAGE_A(bufoff, aptr, h, nx) do { if constexpr (GATHER) { const unsigned _o0 = (nx) ? vAn[h][0] : vAc[h][0], _o1 = (nx) ? vAn[h][1] : vAc[h][1]; PG8_STAGE2(bufoff, aptr, _o0, _o1); } \
        else { PG8_STAGE2(bufoff, (aptr) + (h) * hstep, voffA[0], voffA[1]); } } while (0)
#define PG8_GOFF(dst, uidx) do { _Pragma("unroll") for (int _h = 0; _h < 2; ++_h) _Pragma("unroll") for (int _i = 0; _i < 2; ++_i) { \
        const unsigned _code = rowtab[(uidx) * 256 + _h * 128 + RA[_i]]; const unsigned _tok = (_code == 0xFFFFFFFFu) ? 0u : (_code >> 1); dst[_h][_i] = _tok * (unsigned)(K * 2) + CA2[_i]; } } while (0)
#define PG8_LDA(dst, b, h) do { _Pragma("unroll") for (int m = 0; m < 4; ++m) _Pragma("unroll") for (int k = 0; k < 2; ++k) dst[m][k] = *(const LAS h16x8*)(lds + PG8_SA(b, h) + aoff + m * 2048 + k * 1024); } while (0)
#define PG8_LDB(dst, b, h) do { _Pragma("unroll") for (int n = 0; n < 2; ++n) _Pragma("unroll") for (int k = 0; k < 2; ++k) dst[n][k] = *(const LAS h16x8*)(lds + PG8_SB(b, h) + boff + n * 2048 + k * 1024); } while (0)
#define PG8_MMA(ai, bj, At, Bt) do { __builtin_amdgcn_s_setprio(1); _Pragma("unroll") for (int m = 0; m < 4; ++m) _Pragma("unroll") for (int n = 0; n < 2; ++n) _Pragma("unroll") for (int k = 0; k < 2; ++k) \
        acc[ai][bj][m][n] = __builtin_amdgcn_mfma_f32_16x16x32_f16(Bt[n][k], At[m][k], acc[ai][bj][m][n], 0, 0, 0); __builtin_amdgcn_s_setprio(0); } while (0)
#define PG8_WAIT_V(n) asm volatile("s_waitcnt vmcnt(" #n ")" ::: "memory")
#define PG8_WAIT_L(n) asm volatile("s_waitcnt lgkmcnt(" #n ")" ::: "memory")
#define PG8_BAR __builtin_amdgcn_s_barrier()
#define PG8_SCHED __builtin_amdgcn_sched_barrier(0)
    Unit cur, nxt; int ui = 0;
    if (!S.next(0, cur)) return;
    if constexpr (GATHER) { PG8_GOFF(vAc, cur.idx); }
    f32x4 acc[2][2][4][2];
#pragma unroll
    for (int a = 0; a < 2; ++a)
#pragma unroll
        for (int b = 0; b < 2; ++b)
#pragma unroll
            for (int m = 0; m < 4; ++m)
#pragma unroll
                for (int n = 0; n < 2; ++n) acc[a][b][m][n] = (f32x4){0.f, 0.f, 0.f, 0.f};
    h16x8 At[4][2], B0[2][2], B1[2][2];
    const char* cA = cur.A; const char* cB = cur.B;
    PG8_STAGE_B(PG8_SB(0, 0), cB); PG8_STAGE_B(PG8_SB(0, 1), cB + hstep); PG8_STAGE_A(PG8_SA(0, 0), cA, 0, false); PG8_STAGE_A(PG8_SA(0, 1), cA, 1, false);
    if (wr == 1) PG8_BAR;
    PG8_WAIT_V(2); PG8_BAR;
    PG8_STAGE_B(PG8_SB(1, 0), cB + kstep); PG8_STAGE_A(PG8_SA(1, 0), cA + kstep, 0, false); PG8_STAGE_B(PG8_SB(1, 1), cB + hstep + kstep);
    PG8_WAIT_V(6); PG8_BAR;
    for (;;) {
        const bool has_next = S.next(ui + 1, nxt);
        if constexpr (GATHER) {
            if (has_next) { PG8_GOFF(vAn, nxt.idx); }
            else {
#pragma unroll
                for (int h = 0; h < 2; ++h)
#pragma unroll
                    for (int i = 0; i < 2; ++i) vAn[h][i] = vAc[h][i];
            }
        }
        const char* nA = has_next ? nxt.A : cA; const char* nB = has_next ? nxt.B : cB;
        for (int t = 0; t < nt; t += 2) {
            const bool last = (t == nt - 2);
            const char* a1 = cA + (size_t)(t + 1) * kstep;
            const char* a2 = last ? nA : cA + (size_t)(t + 2) * kstep; const char* b2 = last ? nB : cB + (size_t)(t + 2) * kstep;
            const char* a3 = a2 + kstep; const char* b3 = b2 + kstep;
            PG8_LDB(B0, 0, 0); PG8_LDB(B1, 0, 1); PG8_SCHED; PG8_LDA(At, 0, 0); PG8_STAGE_A(PG8_SA(1, 1), a1, 1, false);
            PG8_WAIT_V(8); PG8_WAIT_L(0); PG8_BAR; PG8_MMA(0, 0, At, B0); PG8_MMA(0, 1, At, B1); PG8_BAR; PG8_SCHED;
            PG8_LDA(At, 0, 1); PG8_STAGE_B(PG8_SB(0, 0), b2); PG8_STAGE_B(PG8_SB(0, 1), b2 + hstep); PG8_STAGE_A(PG8_SA(0, 0), a2, 0, last);
            PG8_WAIT_V(8); PG8_WAIT_L(0); PG8_BAR; PG8_MMA(1, 0, At, B0); PG8_MMA(1, 1, At, B1); PG8_BAR; PG8_SCHED;
            PG8_LDB(B0, 1, 0); PG8_LDB(B1, 1, 1); PG8_SCHED; PG8_LDA(At, 1, 0); PG8_STAGE_A(PG8_SA(0, 1), a2, 1, last);
            PG8_WAIT_V(8); PG8_WAIT_L(0); PG8_BAR; PG8_MMA(0, 0, At, B0); PG8_MMA(0, 1, At, B1); PG8_BAR; PG8_SCHED;
            PG8_LDA(At, 1, 1); PG8_STAGE_B(PG8_SB(1, 0), b3); PG8_STAGE_B(PG8_SB(1, 1), b3 + hstep); PG8_STAGE_A(PG8_SA(1, 0), a3, 0, last);
            PG8_WAIT_V(8); PG8_WAIT_L(0); PG8_BAR; PG8_MMA(1, 0, At, B0); PG8_MMA(1, 1, At, B1); PG8_BAR; PG8_SCHED;
        }
        if (wr == 0) PG8_BAR;
        E(acc, cur, wr, wc, fr, fq);
        if (!has_next) break;
#pragma unroll
        for (int a = 0; a < 2; ++a)
#pragma unroll
            for (int b = 0; b < 2; ++b)
#pragma unroll
                for (int m = 0; m < 4; ++m)
#pragma unroll
                    for (int n = 0; n < 2; ++n) acc[a][b][m][n] = (f32x4){0.f, 0.f, 0.f, 0.f};
        cur = nxt; cA = nA; cB = nB; ++ui;
        if constexpr (GATHER) {
#pragma unroll
            for (int h = 0; h < 2; ++h)
#pragma unroll
                for (int i = 0; i < 2; ++i) vAc[h][i] = vAn[h][i];
        }
        if (wr == 1) PG8_BAR;
    }
    PG8_WAIT_V(0);
    PG8_BAR;
#undef PG8_SA
#undef PG8_SB
#undef PG8_STAGE2
#undef PG8_STAGE_A
#undef PG8_STAGE_B
#undef PG8_GOFF
#undef PG8_LDA
#undef PG8_LDB
#undef PG8_MMA
#undef PG8_WAIT_V
#undef PG8_WAIT_L
#undef PG8_BAR
#undef PG8_SCHED
}

struct EpiInProj {
    static constexpr bool PERM = true; h16* O;
    __device__ __forceinline__ void operator()(const f32x4 (&acc)[2][2][4][2], const Unit& u, int wr, int wc, int fr, int fq) const {
        const int row0 = u.pm * BM + wr * 64 + fr, col0 = u.pn * BM + wc * 32 + 8 * fq; const bool act = u.pn < 8;
#pragma unroll
        for (int ai = 0; ai < 2; ++ai)
#pragma unroll
            for (int m = 0; m < 4; ++m) { h16* rowp = O + (size_t)(row0 + ai * HALF + m * 16) * INC + col0;
#pragma unroll
                for (int bj = 0; bj < 2; ++bj) { f32x4 v0 = acc[ai][bj][m][0], v1 = acc[ai][bj][m][1];
                    if (act) {
#pragma unroll
                        for (int i = 0; i < 4; ++i) { v0[i] = gelu_t(v0[i]); v1[i] = gelu_t(v1[i]); } }
                    u32x4 w; w.x = pkh(v0[0], v0[1]); w.y = pkh(v0[2], v0[3]); w.z = pkh(v1[0], v1[1]); w.w = pkh(v1[2], v1[3]);
                    *(u32x4*)(rowp + bj * HALF) = w; } }
    }
};
struct EpiOutProj {
    static constexpr bool PERM = false; const float* x; const float* mod; float* x1;
    __device__ __forceinline__ void operator()(const f32x4 (&acc)[2][2][4][2], const Unit& u, int wr, int wc, int fr, int fq) const {
        const int b = u.pm >> 3; const int col0 = u.pn * BM + wc * 32 + 4 * fq;
        f32x4 gv[2][2];
#pragma unroll
        for (int bj = 0; bj < 2; ++bj)
#pragma unroll
            for (int n = 0; n < 2; ++n) gv[bj][n] = *(const f32x4*)(mod + (size_t)b * NMOD + 2 * D + col0 + bj * HALF + n * 16);
#pragma unroll
        for (int ai = 0; ai < 2; ++ai)
#pragma unroll
            for (int m = 0; m < 4; ++m) { const size_t off = (size_t)(u.pm * BM + ai * HALF + wr * 64 + m * 16 + fr) * D + col0;
#pragma unroll
                for (int bj = 0; bj < 2; ++bj)
#pragma unroll
                    for (int n = 0; n < 2; ++n) { const f32x4 xv = *(const f32x4*)(x + off + bj * HALF + n * 16);
                        *(f32x4*)(x1 + off + bj * HALF + n * 16) = xv + gv[bj][n] * acc[ai][bj][m][n]; }
                if (m & 1) asm volatile("" ::: "memory"); }
    }
};
struct EpiUp {
    static constexpr bool PERM = true; h16* act;
    __device__ __forceinline__ void operator()(const f32x4 (&acc)[2][2][4][2], const Unit& u, int wr, int wc, int fr, int fq) const {
        const int col0 = u.pn * HALF + wc * 32 + 8 * fq;
#pragma unroll
        for (int ai = 0; ai < 2; ++ai)
#pragma unroll
            for (int m = 0; m < 4; ++m) { const int r = ai * HALF + wr * 64 + m * 16 + fr;
                f32x4 v0, v1;
#pragma unroll
                for (int i = 0; i < 4; ++i) { v0[i] = silu_f(acc[ai][0][m][0][i]) * acc[ai][1][m][0][i]; v1[i] = silu_f(acc[ai][0][m][1][i]) * acc[ai][1][m][1][i]; }
                u32x4 w; w.x = pkh(v0[0], v0[1]); w.y = pkh(v0[2], v0[3]); w.z = pkh(v1[0], v1[1]); w.w = pkh(v1[2], v1[3]);
                *(u32x4*)(act + (size_t)(u.pm * BM + r) * DE + col0) = w; }
    }
};
struct EpiDown {
    static constexpr bool PERM = true; h16* yb; const LAS unsigned* rowt; const LAS float* gatet;
    __device__ __forceinline__ void operator()(const f32x4 (&acc)[2][2][4][2], const Unit& u, int wr, int wc, int fr, int fq) const {
        const int col0 = u.pn * BM + wc * 32 + 8 * fq;
#pragma unroll
        for (int ai = 0; ai < 2; ++ai)
#pragma unroll
            for (int m = 0; m < 4; ++m) { const int r = ai * HALF + wr * 64 + m * 16 + fr;
                const unsigned code = rowt[u.idx * 256 + r]; const float g = gatet[u.idx * 256 + r];
                if (code != 0xFFFFFFFFu) { h16* rowp = yb + ((size_t)(code & 1u) * T + (code >> 1)) * D + col0;
#pragma unroll
                    for (int bj = 0; bj < 2; ++bj) { const f32x4 v0 = acc[ai][bj][m][0] * g, v1 = acc[ai][bj][m][1] * g;
                        u32x4 w; w.x = pkh(v0[0], v0[1]); w.y = pkh(v0[2], v0[3]); w.z = pkh(v1[0], v1[1]); w.w = pkh(v1[2], v1[3]);
                        *(u32x4*)(rowp + bj * HALF) = w; } } }
    }
};
}

#define XB_TMO      128
#define XB_XCNT(j)  (256  + 64 * (j))
#define XB_XSUB(j)  (1280 + 64 * (j))
#define XB_XGEN(j)  (2304 + 64 * (j))
#define XB_TOP      3328
#define XB_TOPGEN   3392
#define XCD_BAR_WORDS 3456
#define XB_SPIN_CAP (1u << 18)
__device__ __forceinline__ unsigned xb_ld(unsigned* p)              { return __hip_atomic_load(p, __ATOMIC_RELAXED, __HIP_MEMORY_SCOPE_AGENT); }
__device__ __forceinline__ unsigned xb_add(unsigned* p, unsigned v) { return __hip_atomic_fetch_add(p, v, __ATOMIC_RELAXED, __HIP_MEMORY_SCOPE_AGENT); }
__device__ __forceinline__ unsigned xb_xcc_id() { return (unsigned)__builtin_amdgcn_s_getreg((3 << 11) | 20) & 0xFu; }
#define XB_SPIN(cond, bar) do { unsigned _sp = 0; while (cond) { __builtin_amdgcn_s_sleep(1); \
    if ((++_sp & 255u) == 0u) { if (xb_ld(&(bar)[XB_TMO])) break; if (_sp > XB_SPIN_CAP) { atomicAdd(&(bar)[XB_TMO], 1u); break; } } } } while (0)
struct XcdBarrier { unsigned* bar; unsigned x; volatile LAS unsigned* st; };
__device__ __forceinline__ XcdBarrier xcd_barrier_post(unsigned* bar, volatile LAS unsigned* st) {
    XcdBarrier b; b.bar = bar; b.x = xb_xcc_id(); b.st = st;
    if (threadIdx.x == 0) (void)xb_add(&bar[XB_XCNT(b.x)], 1u);
    return b;
}
__device__ __forceinline__ void xcd_barrier_complete(unsigned* bar, unsigned x, unsigned& nloc, unsigned& nx) {
    const unsigned G = gridDim.x * gridDim.y * gridDim.z;
    unsigned sum, cnt, mine, sp = 0u;
    for (;;) {
        sum = 0u; cnt = 0u; mine = 0u;
#pragma unroll
        for (unsigned j = 0; j < 16; ++j) { const unsigned c = xb_ld(&bar[XB_XCNT(j)]); sum += c; cnt += (c > 0u) ? 1u : 0u; mine = (j == x) ? c : mine; }
        if (sum == G) break;
        __builtin_amdgcn_s_sleep(1);
        if ((++sp & 255u) == 0u) { if (xb_ld(&bar[XB_TMO])) break; if (sp > XB_SPIN_CAP) { atomicAdd(&bar[XB_TMO], 1u); break; } }
    }
    nloc = mine > 0u ? mine : 1u; nx = cnt > 0u ? cnt : 1u;
}
__device__ __forceinline__ void xcd_barrier(const XcdBarrier& b) {
    asm volatile("s_waitcnt vmcnt(0)" ::: "memory");
    __syncthreads();
    if (threadIdx.x == 0) {
        unsigned* bar = b.bar;
        __builtin_amdgcn_s_waitcnt(0);
        unsigned nloc = b.st[0], nx = b.st[1];
        if (nloc == 0u) { xcd_barrier_complete(bar, b.x, nloc, nx); b.st[0] = nloc; b.st[1] = nx; }
        const unsigned old = xb_add(&bar[XB_XSUB(b.x)], 1u);
        const unsigned gen = old / nloc;
        if (old + 1u == (gen + 1u) * nloc) {
            __builtin_amdgcn_fence(__ATOMIC_RELEASE, "agent");
            asm volatile("s_waitcnt vmcnt(0)" ::: "memory");
            const unsigned og = xb_add(&bar[XB_TOP], 1u);
            const unsigned tg = og / nx;
            if (og + 1u == (tg + 1u) * nx) xb_add(&bar[XB_TOPGEN], 1u);
            else XB_SPIN(xb_ld(&bar[XB_TOPGEN]) == tg, bar);
            __builtin_amdgcn_fence(__ATOMIC_ACQUIRE, "agent");
            xb_add(&bar[XB_XGEN(b.x)], 1u);
            asm volatile("s_waitcnt vmcnt(0)" ::: "memory");
        } else {
            XB_SPIN(xb_ld(&bar[XB_XGEN(b.x)]) == gen, bar);
            __builtin_amdgcn_fence(__ATOMIC_ACQUIRE, "agent");
            asm volatile("s_waitcnt vmcnt(0)" ::: "memory");
        }
    }
    __syncthreads();
}

struct Args { const float* in[22]; float* out; unsigned char* ws; int ph_lo, ph_hi; };
enum { I_X = 0, I_C, I_WADA, I_BADA, I_N1G, I_WIN, I_WOUT, I_WS, I_BS, I_VG, I_CW, I_CB, I_N2G, I_WRG, I_BRG, I_WRE, I_BRE, I_WGU, I_WD, I_WAF, I_BAF, I_NFG };

__device__ __forceinline__ void p0_transpose_item(const float* W, int K, int N, h16* WT, LAS float* scr, int item, int lane, int mode) {
    const int nblk = N / 32, kb = item / nblk, nb = item % nblk, k0 = 64 * kb, n0 = 32 * nb;
#pragma unroll 8
    for (int i = 0; i < 32; ++i) { const int kk = 2 * i + (lane >> 5); scr[kk * 33 + (lane & 31)] = W[(size_t)(k0 + kk) * N + n0 + (lane & 31)]; }
    asm volatile("s_waitcnt lgkmcnt(0)" ::: "memory");
    int r0 = n0;
    if (mode == 1) { const int nn = n0 & 511; r0 = 256 * (nn >> 7) + ((n0 >> 9) << 7) + (nn & 127); }
    const int c = lane & 7;
#pragma unroll
    for (int j = 0; j < 4; ++j) { const int n = (lane >> 3) + 8 * j; const LAS float* s = scr + (8 * c) * 33 + n;
        u32x4 o; o.x = pkh(s[0 * 33], s[1 * 33]); o.y = pkh(s[2 * 33], s[3 * 33]); o.z = pkh(s[4 * 33], s[5 * 33]); o.w = pkh(s[6 * 33], s[7 * 33]);
        *(u32x4*)(WT + (size_t)(r0 + n) * K + k0 + 8 * c) = o; }
    asm volatile("s_waitcnt lgkmcnt(0)" ::: "memory");
}

__global__ void __launch_bounds__(512, 2) mk_fwd(Args args) {
    extern __shared__ __attribute__((aligned(16))) unsigned char lds_raw[];
    LAS unsigned char* lds = (LAS unsigned char*)lds_raw;
    const int tid = threadIdx.x, lane = tid & 63, wave = __builtin_amdgcn_readfirstlane(tid >> 6);
    const int G = gridDim.x, blk = blockIdx.x;
    const int gw = blk * 8 + wave, NGW = G * 8;
    unsigned char* ws = args.ws;
    unsigned* ctl = (unsigned*)(ws + WS_CTL);
    float* mod = (float*)(ws + WS_MOD); float* modf = (float*)(ws + WS_MODF); float* sw = (float*)(ws + WS_SW);
    h16* WrH = (h16*)(ws + WS_WRH); h16* WrL = (h16*)(ws + WS_WRL);
    unsigned* lcode = (unsigned*)(ws + WS_LCODE); float* lgate = (float*)(ws + WS_LGATE);
    h16* Win_t = (h16*)(ws + WS_WIN); h16* Wout_t = (h16*)(ws + WS_WOUT); h16* Wgu_t = (h16*)(ws + WS_WGU); h16* Wd_t = (h16*)(ws + WS_WD);
    h16* hb = (h16*)(ws + WS_H); h16* proj = (h16*)(ws + WS_PROJ); h16* yb = (h16*)(ws + WS_Y); h16* actb = (h16*)(ws + WS_ACT); h16* ybuf = (h16*)(ws + WS_YB);
    float* x1 = args.out;
    const float* x = args.in[I_X];

    for (int u = tid; u < (LDS_BYTES - RING_BYTES) / 4; u += 512) ((LAS unsigned*)(lds + RING_BYTES))[u] = 0u;
    __syncthreads();
    XcdBarrier bar; bar.bar = ctl + CW_BAR; bar.x = 0; bar.st = nullptr;
    if (MK_N_LAUNCHES == 1) bar = xcd_barrier_post(ctl + CW_BAR, (volatile LAS unsigned*)(lds + MISC_OFF) + 8);
    const int lo = args.ph_lo, hi = args.ph_hi;
#define IN(k) (lo <= (k) && (k) < hi)
#define SEAM(k) do { if (IN(k) && IN((k) + 1)) xcd_barrier(bar); } while (0)

    if (IN(0)) {
        LAS float* CA = (LAS float*)lds; LAS float* RED = (LAS float*)(lds + 65536);
        const float* c = args.in[I_C];
        for (int idx = tid; idx < NB * D; idx += 512) { const int b = idx >> 11, d = idx & 2047; const float v = c[idx]; CA[d * 8 + b] = v / (1.0f + __expf(-v)); }
        __syncthreads();
        for (int cb = blk; cb < 256; cb += G) {
            const float* W; int N, col0; float* outp; const float* bias;
            if (cb < 192) { W = args.in[I_WADA]; N = NMOD; col0 = cb * 64; outp = mod; bias = args.in[I_BADA]; }
            else { W = args.in[I_WAF]; N = NMODF; col0 = (cb - 192) * 64; outp = modf; bias = args.in[I_BAF]; }
            const int dsub = lane >> 4, cq = lane & 15;
            float acc[8][4];
#pragma unroll
            for (int b = 0; b < 8; ++b)
#pragma unroll
                for (int j = 0; j < 4; ++j) acc[b][j] = 0.f;
            const float* wp = W + (size_t)(wave * 256 + dsub) * N + col0 + 4 * cq;
#pragma unroll 8
            for (int it = 0; it < 64; ++it) {
                const f32x4 wv = *(const f32x4*)(wp + (size_t)it * 4 * N);
                const int d = wave * 256 + it * 4 + dsub;
                const f32x4 c0 = *(const LAS f32x4*)&CA[d * 8], c1 = *(const LAS f32x4*)&CA[d * 8 + 4];
#pragma unroll
                for (int j = 0; j < 4; ++j) {
                    acc[0][j] += c0[0] * wv[j]; acc[1][j] += c0[1] * wv[j]; acc[2][j] += c0[2] * wv[j]; acc[3][j] += c0[3] * wv[j];
                    acc[4][j] += c1[0] * wv[j]; acc[5][j] += c1[1] * wv[j]; acc[6][j] += c1[2] * wv[j]; acc[7][j] += c1[3] * wv[j]; }
            }
#pragma unroll
            for (int b = 0; b < 8; ++b)
#pragma unroll
                for (int j = 0; j < 4; ++j) { float v = acc[b][j]; v += __shfl_xor(v, 16); v += __shfl_xor(v, 32); acc[b][j] = v; }
            if (dsub == 0) {
#pragma unroll
                for (int b = 0; b < 8; ++b) *(LAS f32x4*)&RED[(wave * 8 + b) * 64 + 4 * cq] = (f32x4){acc[b][0], acc[b][1], acc[b][2], acc[b][3]};
            }
            __syncthreads();
            { const int b = tid >> 6, col = tid & 63; float s = bias[col0 + col];
#pragma unroll
              for (int w = 0; w < 8; ++w) s += RED[(w * 8 + b) * 64 + col];
              outp[(size_t)b * N + col0 + col] = s; }
            __syncthreads();
        }
        for (int idx = blk * 512 + tid; idx < NRP * D; idx += G * 512) { const int n = idx >> 11, k = idx & 2047; float w = 0.f;
            if (n < 4) w = args.in[I_WRG][k * 4 + n]; else if (n < 36) w = args.in[I_WRE][k * 32 + (n - 4)];
            w *= 1024.0f; const h16 hi_ = (h16)w; const h16 lo_ = (h16)(w - (float)hi_); WrH[idx] = hi_; WrL[idx] = lo_; }
        LAS float* scr = (LAS float*)(lds + wave * 16384);
        constexpr int I_IN = (D / 64) * (INC / 32), I_OUT = (D / 64) * (D / 32), I_GU1 = (D / 64) * (GU / 32), I_D1 = (DE / 64) * (D / 32);
        constexpr int NITEMS = I_IN + I_OUT + NE * I_GU1 + NE * I_D1;
        for (int it = gw; it < NITEMS; it += NGW) {
            int r = it;
            if (r < I_IN) { p0_transpose_item(args.in[I_WIN], D, INC, Win_t, scr, r, lane, 0); continue; } r -= I_IN;
            if (r < I_OUT) { p0_transpose_item(args.in[I_WOUT], D, D, Wout_t, scr, r, lane, 0); continue; } r -= I_OUT;
            if (r < NE * I_GU1) { const int e = r / I_GU1; p0_transpose_item(args.in[I_WGU] + (size_t)e * D * GU, D, GU, Wgu_t + (size_t)e * GU * D, scr, r % I_GU1, lane, 1); continue; } r -= NE * I_GU1;
            { const int e = r / I_D1; p0_transpose_item(args.in[I_WD] + (size_t)e * DE * D, DE, D, Wd_t + (size_t)e * D * DE, scr, r % I_D1, lane, 0); }
        }
    }
    SEAM(0);

    if (IN(1)) {
        const float* g1 = args.in[I_N1G];
        for (int rb = gw; rb < T / 8; rb += NGW) {
            const int b = (rb * 8) >> 11;
            f32x4 ca[8], cs[8];
#pragma unroll
            for (int j = 0; j < 8; ++j) { const int col = 4 * lane + 256 * j; const f32x4 g = *(const f32x4*)(g1 + col), sc = *(const f32x4*)(mod + (size_t)b * NMOD + D + col);
                ca[j] = g * (sc + 1.0f); cs[j] = *(const f32x4*)(mod + (size_t)b * NMOD + col); }
            for (int r = 0; r < 8; ++r) { const int row = rb * 8 + r; const f32x4* xr = (const f32x4*)(x + (size_t)row * D) + lane;
                f32x4 v[8]; float ss = 0.f;
#pragma unroll
                for (int j = 0; j < 8; ++j) { v[j] = xr[64 * j]; ss += (v[j][0] * v[j][0] + v[j][1] * v[j][1]) + (v[j][2] * v[j][2] + v[j][3] * v[j][3]); }
                const float rstd = 1.0f / sqrtf(wave_sum(ss) * (1.0f / D) + EPS);
                u32x2* o = (u32x2*)(hb + (size_t)row * D) + lane;
#pragma unroll
                for (int j = 0; j < 8; ++j) { const f32x4 y = v[j] * rstd * ca[j] + cs[j]; u32x2 w; w.x = pkh(y[0], y[1]); w.y = pkh(y[2], y[3]); o[64 * j] = w; }
            }
        }
        for (int q = gw; q < NB * 36; q += NGW) { const int b = q / 36, j = q % 36; float s = 0.f;
            for (int d = lane; d < D; d += 64) { const float w = (j < 4) ? args.in[I_WRG][d * 4 + j] : args.in[I_WRE][d * 32 + (j - 4)]; s += mod[(size_t)b * NMOD + 3 * D + d] * w; }
            s = wave_sum(s); if (lane == 0) sw[b * NRP + j] = s + ((j < 4) ? args.in[I_BRG][j] : args.in[I_BRE][j - 4]); }
    }
    SEAM(1);

    if (IN(2)) {
        pg8::DenseOrder S; S.init(hb, Win_t, T, INC, D, G, blk);
        pg8::EpiInProj E{proj};
        pg8::gemm_phase<pg8::EpiInProj, pg8::DenseOrder, false>(lds, D, S, E, nullptr);
    }
    SEAM(2);

    if (IN(3)) {
        LAS h16* WL = (LAS h16*)lds; LAS h16* VT = (LAS h16*)(lds + 34816);
        for (int job = blk; job < 256; job += G) {
            const int hh = job & 7, pg = job >> 3;
            __syncthreads();
            { const int t = tid >> 2, q0 = (tid & 3) * 32; const float* wrow = args.in[I_WS] + ((size_t)hh * 128 + t) * 128 + q0;
#pragma unroll
              for (int i = 0; i < 4; ++i) { const f32x4 a = *(const f32x4*)(wrow + 8 * i), bq = *(const f32x4*)(wrow + 8 * i + 4); const int q = q0 + 8 * i;
                  u32x4 w; w.x = pkh(q + 0 <= t ? a[0] : 0.f, q + 1 <= t ? a[1] : 0.f); w.y = pkh(q + 2 <= t ? a[2] : 0.f, q + 3 <= t ? a[3] : 0.f);
                  w.z = pkh(q + 4 <= t ? bq[0] : 0.f, q + 5 <= t ? bq[1] : 0.f); w.w = pkh(q + 6 <= t ? bq[2] : 0.f, q + 7 <= t ? bq[3] : 0.f);
                  *(LAS u32x4*)(WL + t * 136 + q) = w; } }
            const int q = tid >> 2, d0 = (tid & 3) * 32;
            for (int pi = 0; pi < 4; ++pi) {
                const int pair = pg * 4 + pi, tok0 = (pair >> 4) * SEQ + (pair & 15) * 128;
                { const h16* vrow = proj + (size_t)(tok0 + q) * INC + AW + hh * 128 + d0; const float* gn = args.in[I_VG] + hh * 128 + d0;
                  h16x8 v[4]; float ss = 0.f;
#pragma unroll
                  for (int i = 0; i < 4; ++i) { v[i] = *(const h16x8*)(vrow + 8 * i);
#pragma unroll
                      for (int j = 0; j < 8; ++j) { const float f = (float)v[i][j]; ss += f * f; } }
                  ss += __shfl_xor(ss, 1); ss += __shfl_xor(ss, 2);
                  const float rstd = 1.0f / sqrtf(ss * (1.0f / 128.0f) + EPS);
#pragma unroll
                  for (int i = 0; i < 4; ++i) { const f32x4 g0 = *(const f32x4*)(gn + 8 * i), g1v = *(const f32x4*)(gn + 8 * i + 4);
#pragma unroll
                      for (int j = 0; j < 8; ++j) { const float g = j < 4 ? g0[j & 3] : g1v[j & 3]; VT[(d0 + 8 * i + j) * 136 + q] = (h16)((float)v[i][j] * rstd * g); } } }
                __syncthreads();
                { const int fr = lane & 15, fq = lane >> 4; f32x4 acc[8];
#pragma unroll
                  for (int n = 0; n < 8; ++n) acc[n] = (f32x4){0.f, 0.f, 0.f, 0.f};
                  const int nks = (wave >> 1) + 1;
                  for (int ks = 0; ks < nks; ++ks) { const h16x8 wf = *(const LAS h16x8*)(WL + (16 * wave + fr) * 136 + 32 * ks + 8 * fq);
#pragma unroll
                      for (int n = 0; n < 8; ++n) { const h16x8 vf = *(const LAS h16x8*)(VT + (16 * n + fr) * 136 + 32 * ks + 8 * fq); acc[n] = __builtin_amdgcn_mfma_f32_16x16x32_f16(vf, wf, acc[n], 0, 0, 0); } }
                  const int t = 16 * wave + fr; const float bs = args.in[I_BS][hh * 128 + t];
                  const h16* urow = proj + (size_t)(tok0 + t) * INC + hh * 128 + 4 * fq; h16* yrow = yb + (size_t)(tok0 + t) * D + hh * 128 + 4 * fq;
#pragma unroll
                  for (int n = 0; n < 8; ++n) { const h16x4 uv = *(const h16x4*)(urow + 16 * n);
                      u32x2 w; w.x = pkh((float)uv[0] * (acc[n][0] + bs), (float)uv[1] * (acc[n][1] + bs)); w.y = pkh((float)uv[2] * (acc[n][2] + bs), (float)uv[3] * (acc[n][3] + bs));
                      *(u32x2*)(yrow + 16 * n) = w; } }
                __syncthreads();
            }
        }
        for (int job = blk; job < 256; job += G) {
            const int ch = (tid & 127) * 8, t0 = job * 64 + (tid >> 7) * 16;
            float w0[8], w1[8], w2[8], cbv[8];
#pragma unroll
            for (int j = 0; j < 8; ++j) { w0[j] = args.in[I_CW][ch + j]; w1[j] = args.in[I_CW][1024 + ch + j]; w2[j] = args.in[I_CW][2048 + ch + j]; cbv[j] = args.in[I_CB][ch + j]; }
            float p1[8], p2[8];
            if ((t0 & (SEQ - 1)) == 0) {
#pragma unroll
                for (int j = 0; j < 8; ++j) { p1[j] = 0.f; p2[j] = 0.f; }
            } else {
                const h16x8 c1 = *(const h16x8*)(proj + (size_t)(t0 - 1) * INC + 3072 + ch), x1v = *(const h16x8*)(proj + (size_t)(t0 - 1) * INC + 4096 + ch);
                const h16x8 c2 = *(const h16x8*)(proj + (size_t)(t0 - 2) * INC + 3072 + ch), x2v = *(const h16x8*)(proj + (size_t)(t0 - 2) * INC + 4096 + ch);
#pragma unroll
                for (int j = 0; j < 8; ++j) { p1[j] = (float)c1[j] * (float)x1v[j]; p2[j] = (float)c2[j] * (float)x2v[j]; }
            }
#pragma unroll 4
            for (int i = 0; i < 16; ++i) { const size_t ro = (size_t)(t0 + i) * INC + ch;
                const h16x8 bg = *(const h16x8*)(proj + ro + 2048), cg = *(const h16x8*)(proj + ro + 3072), xi = *(const h16x8*)(proj + ro + 4096);
                float o[8];
#pragma unroll
                for (int j = 0; j < 8; ++j) { const float pre = (float)cg[j] * (float)xi[j]; o[j] = (float)bg[j] * (w0[j] * p2[j] + w1[j] * p1[j] + w2[j] * pre + cbv[j]); p2[j] = p1[j]; p1[j] = pre; }
                u32x4 w; w.x = pkh(o[0], o[1]); w.y = pkh(o[2], o[3]); w.z = pkh(o[4], o[5]); w.w = pkh(o[6], o[7]);
                *(u32x4*)(yb + (size_t)(t0 + i) * D + AW + ch) = w; }
        }
    }
    SEAM(3);

    if (IN(4)) {
        pg8::DenseOrder S; S.init(yb, Wout_t, T, D, D, G, blk);
        pg8::EpiOutProj E{x, mod, x1};
        pg8::gemm_phase<pg8::EpiOutProj, pg8::DenseOrder, false>(lds, D, S, E, nullptr);
    }
    SEAM(4);

    if (IN(5)) {
        LAS float* GS = (LAS float*)lds; LAS float* SH = (LAS float*)(lds + 8192); LAS float* LG = (LAS float*)(lds + 16384); LAS float* SSP = (LAS float*)(lds + 40960);
        LAS float* LOGIT = (LAS float*)(lds + 41472); LAS float* RSTD = (LAS float*)(lds + 43776);
        LAS int* AE = (LAS int*)(lds + 44032); LAS float* AG = (LAS float*)(lds + 44544); LAS int* HIST = (LAS int*)(lds + 45056); LAS int* BASE = (LAS int*)(lds + 45184);
        const int fr = lane & 15, fq = lane >> 4;
        for (int job = blk; job < 256; job += G) {
            const int b = job >> 5;
            __syncthreads();
            for (int k = tid; k < D; k += 512) { GS[k] = args.in[I_N2G][k] * (1.0f + mod[(size_t)b * NMOD + 4 * D + k]); SH[k] = mod[(size_t)b * NMOD + 3 * D + k]; }
            if (tid < 32) HIST[tid] = 0;
            __syncthreads();
            for (int ti = 0; ti < 4; ++ti) {
                const int tok0 = job * 64 + ti * 16;
                float z[8][8]; f32x4 acc[3]; float ss = 0.f;
#pragma unroll
                for (int n = 0; n < 3; ++n) acc[n] = (f32x4){0.f, 0.f, 0.f, 0.f};
                const float* xrow = x1 + (size_t)(tok0 + fr) * D + 256 * wave + 8 * fq;
                const h16* whp = WrH + (size_t)fr * D + 256 * wave + 8 * fq; const h16* wlp = WrL + (size_t)fr * D + 256 * wave + 8 * fq;
#pragma unroll
                for (int s = 0; s < 8; ++s) {
                    const f32x4 xa = *(const f32x4*)(xrow + 32 * s), xb = *(const f32x4*)(xrow + 32 * s + 4);
                    const f32x4 ga = *(const LAS f32x4*)&GS[256 * wave + 32 * s + 8 * fq], gb = *(const LAS f32x4*)&GS[256 * wave + 32 * s + 8 * fq + 4];
                    h16x8 zh, zl;
#pragma unroll
                    for (int j = 0; j < 4; ++j) { z[s][j] = xa[j] * ga[j]; z[s][4 + j] = xb[j] * gb[j]; ss += xa[j] * xa[j] + xb[j] * xb[j]; }
#pragma unroll
                    for (int j = 0; j < 8; ++j) { zh[j] = (h16)z[s][j]; zl[j] = (h16)(z[s][j] - (float)zh[j]); }
#pragma unroll
                    for (int n = 0; n < 3; ++n) { const h16x8 wh = *(const h16x8*)(whp + (size_t)(16 * n) * D + 32 * s), wl = *(const h16x8*)(wlp + (size_t)(16 * n) * D + 32 * s);
                        acc[n] = __builtin_amdgcn_mfma_f32_16x16x32_f16(wh, zh, acc[n], 0, 0, 0);
                        acc[n] = __builtin_amdgcn_mfma_f32_16x16x32_f16(wl, zh, acc[n], 0, 0, 0);
                        acc[n] = __builtin_amdgcn_mfma_f32_16x16x32_f16(wh, zl, acc[n], 0, 0, 0); }
                }
                ss += __shfl_xor(ss, 16); ss += __shfl_xor(ss, 32);
                if (fq == 0) SSP[wave * 16 + fr] = ss;
#pragma unroll
                for (int n = 0; n < 3; ++n) *(LAS f32x4*)&LG[(wave * 16 + fr) * NRP + 16 * n + 4 * fq] = acc[n];
                __syncthreads();
                for (int idx = tid; idx < 16 * 36; idx += 512) { const int tk = idx / 36, j = idx % 36; float sq = 0.f, lg = 0.f;
#pragma unroll
                    for (int w = 0; w < 8; ++w) { sq += SSP[w * 16 + tk]; lg += LG[(w * 16 + tk) * NRP + j]; }
                    const float rstd = 1.0f / sqrtf(sq * (1.0f / D) + EPS);
                    LOGIT[tk * 36 + j] = lg * rstd * (1.0f / 1024.0f) + sw[b * NRP + j]; if (j == 0) RSTD[tk] = rstd; }
                __syncthreads();
                if (tid < 16) {
                    const LAS float* L = LOGIT + tid * 36;
                    int grp = 0; float gm = L[0];
#pragma unroll
                    for (int j = 1; j < 4; ++j) if (L[j] > gm) { gm = L[j]; grp = j; }
                    float den = 0.f;
#pragma unroll
                    for (int j = 0; j < 4; ++j) den += __expf(L[j] - gm);
                    const float pg_ = 1.0f / den;
                    const LAS float* EL = L + 4 + grp * 8;
                    int i1 = 0; float v1 = EL[0];
#pragma unroll
                    for (int j = 1; j < 8; ++j) if (EL[j] > v1) { v1 = EL[j]; i1 = j; }
                    int i2 = -1; float v2 = -3.0e38f;
#pragma unroll
                    for (int j = 0; j < 8; ++j) if (j != i1 && EL[j] > v2) { v2 = EL[j]; i2 = j; }
                    const float e2 = __expf(v2 - v1), g1_ = pg_ / (1.0f + e2), g2_ = pg_ * e2 / (1.0f + e2);
                    const int a = (ti * 16 + tid) * 2;
                    AE[a] = grp * 8 + i1; AG[a] = g1_; AE[a + 1] = grp * 8 + i2; AG[a + 1] = g2_;
                }
                { const float rstd = RSTD[fr]; h16* hrow = hb + (size_t)(tok0 + fr) * D + 256 * wave + 8 * fq;
#pragma unroll
                  for (int s = 0; s < 8; ++s) { const f32x4 sa = *(const LAS f32x4*)&SH[256 * wave + 32 * s + 8 * fq], sb = *(const LAS f32x4*)&SH[256 * wave + 32 * s + 8 * fq + 4];
                      u32x4 w; w.x = pkh(z[s][0] * rstd + sa[0], z[s][1] * rstd + sa[1]); w.y = pkh(z[s][2] * rstd + sa[2], z[s][3] * rstd + sa[3]);
                      w.z = pkh(z[s][4] * rstd + sb[0], z[s][5] * rstd + sb[1]); w.w = pkh(z[s][6] * rstd + sb[2], z[s][7] * rstd + sb[3]);
                      *(u32x4*)(hrow + 32 * s) = w; } }
                __syncthreads();
            }
            int e_ = 0, rank = 0;
            if (tid < 128) { e_ = AE[tid]; __hip_atomic_fetch_add(&HIST[e_], 1, __ATOMIC_RELAXED, __HIP_MEMORY_SCOPE_WORKGROUP); for (int j = 0; j < tid; ++j) rank += (AE[j] == e_) ? 1 : 0; }
            __syncthreads();
            if (tid < 32) { const int hc = HIST[tid]; BASE[tid] = hc > 0 ? (int)__hip_atomic_fetch_add(ctl + CW_CNT + 64 * tid, (unsigned)hc, __ATOMIC_RELAXED, __HIP_MEMORY_SCOPE_AGENT) : 0; }
            __syncthreads();
            if (tid < 128) { const int pos = BASE[e_] + rank; lcode[(size_t)e_ * T + pos] = (unsigned)((job * 64 + (tid >> 1)) * 2 + (tid & 1)); lgate[(size_t)e_ * T + pos] = AG[tid]; }
        }
    }
    SEAM(5);

    if (IN(6) || IN(7)) {
        LAS int* TAB = (LAS int*)(lds + TAB_OFF); LAS unsigned* ROWT = (LAS unsigned*)(lds + ROWT_OFF); LAS float* GATET = (LAS float*)(lds + GATET_OFF);
        __syncthreads();
        if (tid < 32) TAB[tid] = (int)__hip_atomic_load(ctl + CW_CNT + 64 * tid, __ATOMIC_RELAXED, __HIP_MEMORY_SCOPE_AGENT);
        __syncthreads();
        if (tid == 0) { int s = 0; for (int e = 0; e < NE; ++e) { TAB[32 + e] = s; s += (TAB[e] + 255) >> 8; } TAB[64] = s; }
        __syncthreads();
        const int TT = TAB[64];
        if (IN(6)) {
            pg8::MoeOrder S; S.A = (const char*)hb; S.Bt = (const char*)Wgu_t; S.a_tile = 0; S.b_exp = (size_t)GU * D * 2; S.b_pn = (size_t)256 * D * 2; S.NT = 4; S.nwg = TT * 4; S.G = G; S.c = blk; S.tab = TAB;
            for (int i = 0; i < MAXU; ++i) { pg8::Unit u; if (!S.next(i, u)) break;
                if (tid < 256) { const int pos = (u.pm - TAB[32 + u.e]) * 256 + tid; const bool ok = pos < TAB[u.e]; ROWT[i * 256 + tid] = ok ? lcode[(size_t)u.e * T + pos] : 0xFFFFFFFFu; } }
            __syncthreads();
            pg8::EpiUp E{actb};
            pg8::gemm_phase<pg8::EpiUp, pg8::MoeOrder, true>(lds, D, S, E, ROWT);
        }
        SEAM(6);
        if (IN(7)) {
            pg8::MoeOrder S; S.A = (const char*)actb; S.Bt = (const char*)Wd_t; S.a_tile = (size_t)256 * DE * 2; S.b_exp = (size_t)D * DE * 2; S.b_pn = (size_t)256 * DE * 2; S.NT = 8; S.nwg = TT * 8; S.G = G; S.c = blk; S.tab = TAB;
            __syncthreads();
            for (int i = 0; i < MAXU; ++i) { pg8::Unit u; if (!S.next(i, u)) break;
                if (tid < 256) { const int pos = (u.pm - TAB[32 + u.e]) * 256 + tid; const bool ok = pos < TAB[u.e];
                    ROWT[i * 256 + tid] = ok ? lcode[(size_t)u.e * T + pos] : 0xFFFFFFFFu; GATET[i * 256 + tid] = ok ? lgate[(size_t)u.e * T + pos] : 0.f; } }
            __syncthreads();
            pg8::EpiDown E{ybuf, ROWT, GATET};
            pg8::gemm_phase<pg8::EpiDown, pg8::MoeOrder, false>(lds, DE, S, E, nullptr);
        }
    }
    SEAM(7);

    if (IN(8)) {
        const float* gf = args.in[I_NFG];
        for (int rb = gw; rb < T / 8; rb += NGW) {
            const int b = (rb * 8) >> 11;
            f32x4 cg2[8], ca[8], cs[8];
#pragma unroll
            for (int j = 0; j < 8; ++j) { const int col = 4 * lane + 256 * j; cg2[j] = *(const f32x4*)(mod + (size_t)b * NMOD + 5 * D + col);
                ca[j] = *(const f32x4*)(gf + col) * (*(const f32x4*)(modf + (size_t)b * NMODF + D + col) + 1.0f); cs[j] = *(const f32x4*)(modf + (size_t)b * NMODF + col); }
            for (int r = 0; r < 8; ++r) { const int row = rb * 8 + r; const f32x4* xr = (const f32x4*)(x1 + (size_t)row * D) + lane;
                const h16x4* y0 = (const h16x4*)(ybuf + (size_t)row * D) + lane; const h16x4* y1 = (const h16x4*)(ybuf + ((size_t)T + row) * D) + lane;
                f32x4 v[8]; float ss = 0.f;
#pragma unroll
                for (int j = 0; j < 8; ++j) { const f32x4 xv = xr[64 * j]; const h16x4 a = y0[64 * j], c2 = y1[64 * j];
                    const f32x4 f = {(float)a[0] + (float)c2[0], (float)a[1] + (float)c2[1], (float)a[2] + (float)c2[2], (float)a[3] + (float)c2[3]};
                    v[j] = xv + cg2[j] * f; ss += (v[j][0] * v[j][0] + v[j][1] * v[j][1]) + (v[j][2] * v[j][2] + v[j][3] * v[j][3]); }
                const float rstd = 1.0f / sqrtf(wave_sum(ss) * (1.0f / D) + EPS);
                f32x4* o = (f32x4*)(args.out + (size_t)row * D) + lane;
#pragma unroll
                for (int j = 0; j < 8; ++j) o[64 * j] = v[j] * rstd * ca[j] + cs[j];
            }
        }
    }
#undef IN
#undef SEAM
}

extern "C" void kernel_launch(void* const* d_in, const int* in_sizes, int n_in, void* d_out, int out_size, void* d_ws, size_t ws_size, hipStream_t stream) {
    static int grid = 0;
    if (grid == 0) {
        if (n_in != 22 || in_sizes[0] != T * D || out_size != T * D || ws_size < WS_END) { fprintf(stderr, "kernel_launch: unexpected shapes (n_in %d, in0 %d, out %d, ws %zu); nothing launched\n", n_in, n_in > 0 ? in_sizes[0] : -1, out_size, ws_size); grid = -1; return; }
        int dev = 0, cus = 0, per_cu = 0;
        if (hipGetDevice(&dev) != hipSuccess || hipDeviceGetAttribute(&cus, hipDeviceAttributeMultiprocessorCount, dev) != hipSuccess) { grid = -1; return; }
        if (hipFuncSetAttribute((const void*)mk_fwd, hipFuncAttributeMaxDynamicSharedMemorySize, LDS_BYTES) != hipSuccess) { fprintf(stderr, "kernel_launch: hipFuncSetAttribute failed\n"); grid = -1; return; }
        if (hipOccupancyMaxActiveBlocksPerMultiprocessor(&per_cu, (const void*)mk_fwd, 512, LDS_BYTES) != hipSuccess || per_cu < 1) fprintf(stderr, "kernel_launch: occupancy query reports %d\n", per_cu);
        (void)hipGetLastError();
        grid = cus;
        if (grid > 256) grid = 256;
    }
    if (grid < 0) return;
    if (hipMemsetAsync((char*)d_ws + WS_CTL, 0, CTL_ZERO_BYTES, stream) != hipSuccess) { fprintf(stderr, "kernel_launch: memset failed\n"); return; }
    Args a{};
    for (int i = 0; i < 22; ++i) a.in[i] = (const float*)d_in[i];
    a.out = (float*)d_out; a.ws = (unsigned char*)d_ws;
    if (MK_N_LAUNCHES == 1) { a.ph_lo = 0; a.ph_hi = NPHASE; hipLaunchKernelGGL(mk_fwd, dim3(grid), dim3(512), LDS_BYTES, stream, a); }
    else for (int p = 0; p < NPHASE; ++p) { a.ph_lo = p; a.ph_hi = p + 1; hipLaunchKernelGGL(mk_fwd, dim3(grid), dim3(512), LDS_BYTES, stream, a); }
    const hipError_t le = hipPeekAtLastError();
    if (le != hipSuccess) fprintf(stderr, "kernel_launch: launch failed: %s\n", hipGetErrorName(le));
}
```

```cpp
#include <hip/hip_runtime.h>
#include <cstdio>
#include <cstdint>

#ifndef MK_N_LAUNCHES
#define MK_N_LAUNCHES 1
#endif

#ifndef PROBE_PHASE
#define PROBE_PHASE -1
#endif
#define REPS(k) ((PROBE_PHASE == (k)) ? 2 : 1)
#define GAS __attribute__((address_space(1)))
#define LAS __attribute__((address_space(3)))
typedef _Float16 h16;
typedef _Float16 h16x8 __attribute__((ext_vector_type(8)));
typedef _Float16 h16x4 __attribute__((ext_vector_type(4)));
typedef _Float16 h16x2 __attribute__((ext_vector_type(2)));
typedef float f32x4 __attribute__((ext_vector_type(4)));
typedef float f32x2 __attribute__((ext_vector_type(2)));
typedef unsigned u32x4 __attribute__((ext_vector_type(4)));
typedef unsigned u32x2 __attribute__((ext_vector_type(2)));

constexpr int NB = 8, SEQ = 2048, D = 2048, T = NB * SEQ;
constexpr int INC = 5120, AW = 1024, NE = 32, DE = 512, GU = 1024, NMOD = 6 * D, NMODF = 2 * D;
constexpr int NRP = 48;
constexpr float EPS = 1e-6f;
constexpr int MAXTILES = 160, MAXU = 8;
constexpr int NPHASE = 9;

constexpr size_t MiB = 1u << 20;
constexpr size_t WS_CTL = 0, CTL_ZERO_BYTES = 1 * MiB;
constexpr size_t WS_MOD = 1 * MiB, WS_MODF = 1 * MiB + 512 * 1024, WS_SW = 1 * MiB + 768 * 1024;
constexpr size_t WS_WRH = 2 * MiB, WS_WRL = 2 * MiB + 256 * 1024;
constexpr size_t WS_LCODE = 3 * MiB, WS_LGATE = 5 * MiB;
constexpr size_t WS_WIN = 8 * MiB, WS_WOUT = 28 * MiB, WS_WGU = 36 * MiB, WS_WD = 164 * MiB;
constexpr size_t WS_H = 228 * MiB, WS_PROJ = 292 * MiB, WS_Y = 452 * MiB, WS_ACT = 516 * MiB, WS_YB = WS_PROJ, WS_MIX = 556 * MiB, WS_END = 620 * MiB;
constexpr int CW_BAR = 4096, CW_CNT = 16384;

constexpr int RING_BYTES = 131072, MISC_OFF = RING_BYTES + 320, TAB_OFF = RING_BYTES + 1024, ROWT_OFF = TAB_OFF + 512, GATET_OFF = ROWT_OFF + MAXU * 256 * 4;
constexpr int LDS_BYTES = GATET_OFF + MAXU * 256 * 4;
static_assert(LDS_BYTES <= 160 * 1024, "LDS");

__device__ __forceinline__ unsigned pkh(float a, float b) { f32x2 v = {a, b}; h16x2 h = __builtin_convertvector(v, h16x2); return __builtin_bit_cast(unsigned, h); }
__device__ __forceinline__ float gelu_t(float x) {
    const float u = x * (0.7978845608f + 0.0356774081f * x * x);
    return x * __builtin_amdgcn_rcpf(1.0f + __builtin_amdgcn_exp2f(-2.8853900818f * u));
}
__device__ __forceinline__ float silu_f(float x) { return x * __builtin_amdgcn_rcpf(1.0f + __builtin_amdgcn_exp2f(-1.4426950409f * x)); }
__device__ __forceinline__ float wave_sum(float v) {
#pragma unroll
    for (int o = 1; o < 64; o <<= 1) v += __shfl_xor(v, o);
    return v;
}

namespace pg8 {
constexpr int BM = 256, BK = 64, HALF = 128, HTB = HALF * BK * 2, STAGE_BYTES = 8 * HTB, NXCD = 8, WGM = 8;
__host__ __device__ __forceinline__ int lds_byte(int r, int c) { const int st = (r >> 4) * 2 + (c >> 5), rr = r & 15, cc = c & 31, ob = rr * 64 + cc * 2; return st * 1024 + (ob ^ (((ob >> 9) & 1) << 5)); }
__host__ __device__ __forceinline__ void stage_rc(int b, int& R, int& C) { const int st = b / 1024, sb = b % 1024, swz = sb ^ (((sb >> 9) & 1) << 5); R = (st >> 1) * 16 + swz / 64; C = (st & 1) * 32 + (swz % 64) / 2; }
__host__ __device__ __forceinline__ int perm32(int rho) { const int n = rho >> 4, i = rho & 15; return 8 * (i >> 2) + 4 * n + (i & 3); }

struct Unit { const char* A; const char* B; int pm, pn, idx, e, nvalid; };

__device__ __forceinline__ int xcd_remap(int L, int nwg) { const int q = nwg / NXCD, r = nwg % NXCD, xcd = L % NXCD, off = L / NXCD; return (xcd < r ? xcd * (q + 1) : r * (q + 1) + (xcd - r) * q) + off; }

struct DenseOrder {
    const char* A; const char* Bt; size_t tstep; int nM, nN, nwg, G, c;
    __device__ void init(const void* A_, const void* Bt_, int M, int N, int K, int G_, int c_) { A = (const char*)A_; Bt = (const char*)Bt_; tstep = (size_t)BM * K * 2; nM = M / BM; nN = N / BM; nwg = nM * nN; G = G_; c = c_; }
    __device__ __forceinline__ bool next(int i, Unit& u) const {
        const long L = (long)i * G + c; if (L >= nwg) return false;
        const int wgid = xcd_remap((int)L, nwg);
        const int nig = WGM * nN, gid = wgid / nig, fm = gid * WGM, gsz = (nM - fm) < WGM ? (nM - fm) : WGM;
        u.pm = fm + ((wgid % nig) % gsz); u.pn = (wgid % nig) / gsz; u.idx = i; u.e = 0; u.nvalid = BM;
        u.A = A + (size_t)u.pm * tstep; u.B = Bt + (size_t)u.pn * tstep; return true;
    }
};
struct MoeOrder {
    const char* A; const char* Bt; size_t a_tile, b_exp, b_pn; int NT, nwg, G, c; const LAS int* tab;
    __device__ __forceinline__ bool next(int i, Unit& u) const {
        const long L = (long)i * G + c; if (L >= nwg) return false;
        const int wgid = xcd_remap((int)L, nwg);
        const int tile = wgid / NT, pn = wgid % NT;
        int e = 0;
#pragma unroll
        for (int j = 1; j < NE; ++j) e += (tab[32 + j] <= tile) ? 1 : 0;
        e = __builtin_amdgcn_readfirstlane(e);
        const int mt = tile - __builtin_amdgcn_readfirstlane(tab[32 + e]);
        int nv = __builtin_amdgcn_readfirstlane(tab[e]) - mt * BM; nv = nv > BM ? BM : nv;
        u.pm = tile; u.pn = pn; u.idx = i; u.e = e; u.nvalid = nv;
        u.A = A + (size_t)tile * a_tile; u.B = Bt + (size_t)e * b_exp + (size_t)pn * b_pn; return true;
    }
};

template <class Epi, class Sched, bool GATHER>
__device__ __forceinline__ void gemm_phase(LAS unsigned char* lds, const int K, const Sched& S, const Epi& E, const LAS unsigned* rowtab) {
    const int tid = threadIdx.x, wid = __builtin_amdgcn_readfirstlane(tid >> 6), lane = tid & 63, wr = wid >> 2, wc = wid & 3, fr = lane & 15, fq = lane >> 4;
    const int nt = K / BK;
    unsigned voffA[2], voffB[2]; int RA[2]; unsigned CA2[2];
#pragma unroll
    for (int i = 0; i < 2; ++i) { int R, C; stage_rc(tid * 16 + i * 8192, R, C); const int Rb = Epi::PERM ? ((R & ~31) + perm32(R & 31)) : R;
        voffA[i] = (unsigned)(R * K + C) * 2u; voffB[i] = (unsigned)(Rb * K + C) * 2u; RA[i] = R; CA2[i] = (unsigned)C * 2u; }
    const size_t kstep = (size_t)(BK * 2);
    const size_t hstep = (size_t)HALF * K * 2;
    const unsigned ldsw = (unsigned)wid * 1024u;
    const int aoff = lds_byte(wr * 64 + fr, fq * 8), boff = lds_byte(wc * 32 + fr, fq * 8);
    unsigned vAc[2][2], vAn[2][2];
#define PG8_SA(b, h) (((b) * 2 + (h)) * HTB)
#define PG8_SB(b, h) ((4 + (b) * 2 + (h)) * HTB)
#define PG8_STAGE2(bufoff, gbase, o0, o1) do { \
        __builtin_amdgcn_global_load_lds((const unsigned*)((const char*)(gbase) + (o0)), (LAS unsigned*)(lds + (bufoff) + ldsw), 16, 0, 0); \
        __builtin_amdgcn_global_load_lds((const unsigned*)((const char*)(gbase) + (o1)), (LAS unsigned*)(lds + (bufoff) + ldsw + 8192), 16, 0, 0); } while (0)
#define PG8_STAGE_B(bufoff, bptr) PG8_STAGE2(bufoff, bptr, voffB[0], voffB[1])
#define PG8_STAGE_A(bufoff, aptr, h, nx) do { if constexpr (GATHER) { const unsigned _o0 = (nx) ? vAn[h][0] : vAc[h][0], _o1 = (nx) ? vAn[h][1] : vAc[h][1]; PG8_STAGE2(bufoff, aptr, _o0, _o1); } \
        else { PG8_STAGE2(bufoff, (aptr) + (h) * hstep, voffA[0], voffA[1]); } } while (0)
#define PG8_GOFF(dst, uidx) do { _Pragma("unroll") for (int _h = 0; _h < 2; ++_h) _Pragma("unroll") for (int _i = 0; _i < 2; ++_i) { \
        const unsigned _code = rowtab[(uidx) * 256 + _h * 128 + RA[_i]]; const unsigned _tok = (_code == 0xFFFFFFFFu) ? 0u : (_code >> 1); dst[_h][_i] = _tok * (unsigned)(K * 2) + CA2[_i]; } } while (0)
#define PG8_LDA(dst, b, h) do { _Pragma("unroll") for (int m = 0; m < 4; ++m) _Pragma("unroll") for (int k = 0; k < 2; ++k) dst[m][k] = *(const LAS h16x8*)(lds + PG8_SA(b, h) + aoff + m * 2048 + k * 1024); } while (0)
#define PG8_LDB(dst, b, h) do { _Pragma("unroll") for (int n = 0; n < 2; ++n) _Pragma("unroll") for (int k = 0; k < 2; ++k) dst[n][k] = *(const LAS h16x8*)(lds + PG8_SB(b, h) + boff + n * 2048 + k * 1024); } while (0)
#define PG8_MMA(ai, bj, At, Bt) do { __builtin_amdgcn_s_setprio(1); _Pragma("unroll") for (int m = 0; m < 4; ++m) _Pragma("unroll") for (int n = 0; n < 2; ++n) _Pragma("unroll") for (int k = 0; k < 2; ++k) \
        acc[ai][bj][m][n] = __builtin_amdgcn_mfma_f32_16x16x32_f16(Bt[n][k], At[m][k], acc[ai][bj][m][n], 0, 0, 0); __builtin_amdgcn_s_setprio(0); } while (0)
#define PG8_WAIT_V(n) asm volatile("s_waitcnt vmcnt(" #n ")" ::: "memory")
#define PG8_WAIT_L(n) asm volatile("s_waitcnt lgkmcnt(" #n ")" ::: "memory")
#define PG8_BAR __builtin_amdgcn_s_barrier()
#define PG8_SCHED __builtin_amdgcn_sched_barrier(0)
    Unit cur, nxt; int ui = 0;
    if (!S.next(0, cur)) return;
    if constexpr (GATHER) { PG8_GOFF(vAc, cur.idx); }
    f32x4 acc[2][2][4][2];
#pragma unroll
    for (int a = 0; a < 2; ++a)
#pragma unroll
        for (int b = 0; b < 2; ++b)
#pragma unroll
            for (int m = 0; m < 4; ++m)
#pragma unroll
                for (int n = 0; n < 2; ++n) acc[a][b][m][n] = (f32x4){0.f, 0.f, 0.f, 0.f};
    h16x8 At[4][2], B0[2][2], B1[2][2];
    const char* cA = cur.A; const char* cB = cur.B;
    PG8_STAGE_B(PG8_SB(0, 0), cB); PG8_STAGE_B(PG8_SB(0, 1), cB + hstep); PG8_STAGE_A(PG8_SA(0, 0), cA, 0, false); PG8_STAGE_A(PG8_SA(0, 1), cA, 1, false);
    if (wr == 1) PG8_BAR;
    PG8_WAIT_V(2); PG8_BAR;
    PG8_STAGE_B(PG8_SB(1, 0), cB + kstep); PG8_STAGE_A(PG8_SA(1, 0), cA + kstep, 0, false); PG8_STAGE_B(PG8_SB(1, 1), cB + hstep + kstep);
    PG8_WAIT_V(6); PG8_BAR;
    for (;;) {
        const bool has_next = S.next(ui + 1, nxt);
        if constexpr (GATHER) {
            if (has_next) { PG8_GOFF(vAn, nxt.idx); }
            else {
#pragma unroll
                for (int h = 0; h < 2; ++h)
#pragma unroll
                    for (int i = 0; i < 2; ++i) vAn[h][i] = vAc[h][i];
            }
        }
        const char* nA = has_next ? nxt.A : cA; const char* nB = has_next ? nxt.B : cB;
        for (int t = 0; t < nt; t += 2) {
            const bool last = (t == nt - 2);
            const char* a1 = cA + (size_t)(t + 1) * kstep;
            const char* a2 = last ? nA : cA + (size_t)(t + 2) * kstep; const char* b2 = last ? nB : cB + (size_t)(t + 2) * kstep;
            const char* a3 = a2 + kstep; const char* b3 = b2 + kstep;
            PG8_LDB(B0, 0, 0); PG8_LDB(B1, 0, 1); PG8_SCHED; PG8_LDA(At, 0, 0); PG8_STAGE_A(PG8_SA(1, 1), a1, 1, false);
            PG8_WAIT_V(8); PG8_WAIT_L(0); PG8_BAR; PG8_MMA(0, 0, At, B0); PG8_MMA(0, 1, At, B1); PG8_BAR; PG8_SCHED;
            PG8_LDA(At, 0, 1); PG8_STAGE_B(PG8_SB(0, 0), b2); PG8_STAGE_B(PG8_SB(0, 1), b2 + hstep); PG8_STAGE_A(PG8_SA(0, 0), a2, 0, last);
            PG8_WAIT_V(8); PG8_WAIT_L(0); PG8_BAR; PG8_MMA(1, 0, At, B0); PG8_MMA(1, 1, At, B1); PG8_BAR; PG8_SCHED;
            PG8_LDB(B0, 1, 0); PG8_LDB(B1, 1, 1); PG8_SCHED; PG8_LDA(At, 1, 0); PG8_STAGE_A(PG8_SA(0, 1), a2, 1, last);
            PG8_WAIT_V(8); PG8_WAIT_L(0); PG8_BAR; PG8_MMA(0, 0, At, B0); PG8_MMA(0, 1, At, B1); PG8_BAR; PG8_SCHED;
            PG8_LDA(At, 1, 1); PG8_STAGE_B(PG8_SB(1, 0), b3); PG8_STAGE_B(PG8_SB(1, 1), b3 + hstep); PG8_STAGE_A(PG8_SA(1, 0), a3, 0, last);
            PG8_WAIT_V(8); PG8_WAIT_L(0); PG8_BAR; PG8_MMA(1, 0, At, B0); PG8_MMA(1, 1, At, B1); PG8_BAR; PG8_SCHED;
        }
        if (wr == 0) PG8_BAR;
        E(acc, cur, wr, wc, fr, fq);
        if (!has_next) break;
#pragma unroll
        for (int a = 0; a < 2; ++a)
#pragma unroll
            for (int b = 0; b < 2; ++b)
#pragma unroll
                for (int m = 0; m < 4; ++m)
#pragma unroll
                    for (int n = 0; n < 2; ++n) acc[a][b][m][n] = (f32x4){0.f, 0.f, 0.f, 0.f};
        cur = nxt; cA = nA; cB = nB; ++ui;
        if constexpr (GATHER) {
#pragma unroll
            for (int h = 0; h < 2; ++h)
#pragma unroll
                for (int i = 0; i < 2; ++i) vAc[h][i] = vAn[h][i];
        }
        if (wr == 1) PG8_BAR;
    }
    PG8_WAIT_V(0);
    PG8_BAR;
#undef PG8_SA
#undef PG8_SB
#undef PG8_STAGE2
#undef PG8_STAGE_A
#undef PG8_STAGE_B
#undef PG8_GOFF
#undef PG8_LDA
#undef PG8_LDB
#undef PG8_MMA
#undef PG8_WAIT_V
#undef PG8_WAIT_L
#undef PG8_BAR
#undef PG8_SCHED
}

struct EpiInProj {
    static constexpr bool PERM = true; h16* O;
    __device__ __forceinline__ void operator()(const f32x4 (&acc)[2][2][4][2], const Unit& u, int wr, int wc, int fr, int fq) const {
        const int row0 = u.pm * BM + wr * 64 + fr, col0 = u.pn * BM + wc * 32 + 8 * fq; const bool act = u.pn < 8;
#pragma unroll
        for (int ai = 0; ai < 2; ++ai)
#pragma unroll
            for (int m = 0; m < 4; ++m) { h16* rowp = O + (size_t)(row0 + ai * HALF + m * 16) * INC + col0;
#pragma unroll
                for (int bj = 0; bj < 2; ++bj) { f32x4 v0 = acc[ai][bj][m][0], v1 = acc[ai][bj][m][1];
                    if (act) {
#pragma unroll
                        for (int i = 0; i < 4; ++i) { v0[i] = gelu_t(v0[i]); v1[i] = gelu_t(v1[i]); } }
                    u32x4 w; w.x = pkh(v0[0], v0[1]); w.y = pkh(v0[2], v0[3]); w.z = pkh(v1[0], v1[1]); w.w = pkh(v1[2], v1[3]);
                    *(u32x4*)(rowp + bj * HALF) = w; } }
    }
};
struct EpiOutProj {
    static constexpr bool PERM = true; const float* mod; h16* O;
    __device__ __forceinline__ void operator()(const f32x4 (&acc)[2][2][4][2], const Unit& u, int wr, int wc, int fr, int fq) const {
        const int b = u.pm >> 3; const int row0 = u.pm * BM + wr * 64 + fr, col0 = u.pn * BM + wc * 32 + 8 * fq;
        f32x4 gv[2][2];
#pragma unroll
        for (int bj = 0; bj < 2; ++bj)
#pragma unroll
            for (int n = 0; n < 2; ++n) gv[bj][n] = *(const f32x4*)(mod + (size_t)b * NMOD + 2 * D + col0 + bj * HALF + 4 * n);
#pragma unroll
        for (int ai = 0; ai < 2; ++ai)
#pragma unroll
            for (int m = 0; m < 4; ++m) { h16* rowp = O + (size_t)(row0 + ai * HALF + m * 16) * D + col0;
#pragma unroll
                for (int bj = 0; bj < 2; ++bj) { const f32x4 v0 = acc[ai][bj][m][0] * gv[bj][0], v1 = acc[ai][bj][m][1] * gv[bj][1];
                    u32x4 w; w.x = pkh(v0[0], v0[1]); w.y = pkh(v0[2], v0[3]); w.z = pkh(v1[0], v1[1]); w.w = pkh(v1[2], v1[3]);
                    *(u32x4*)(rowp + bj * HALF) = w; } }
    }
};
struct EpiUp {
    static constexpr bool PERM = true; h16* act;
    __device__ __forceinline__ void operator()(const f32x4 (&acc)[2][2][4][2], const Unit& u, int wr, int wc, int fr, int fq) const {
        const int col0 = u.pn * HALF + wc * 32 + 8 * fq;
#pragma unroll
        for (int ai = 0; ai < 2; ++ai)
#pragma unroll
            for (int m = 0; m < 4; ++m) { const int r = ai * HALF + wr * 64 + m * 16 + fr;
                f32x4 v0, v1;
#pragma unroll
                for (int i = 0; i < 4; ++i) { v0[i] = silu_f(acc[ai][0][m][0][i]) * acc[ai][1][m][0][i]; v1[i] = silu_f(acc[ai][0][m][1][i]) * acc[ai][1][m][1][i]; }
                u32x4 w; w.x = pkh(v0[0], v0[1]); w.y = pkh(v0[2], v0[3]); w.z = pkh(v1[0], v1[1]); w.w = pkh(v1[2], v1[3]);
                *(u32x4*)(act + (size_t)(u.pm * BM + r) * DE + col0) = w; }
    }
};
struct EpiDown {
    static constexpr bool PERM = true; h16* yb; const LAS unsigned* rowt; const LAS float* gatet;
    __device__ __forceinline__ void operator()(const f32x4 (&acc)[2][2][4][2], const Unit& u, int wr, int wc, int fr, int fq) const {
        const int col0 = u.pn * BM + wc * 32 + 8 * fq;
#pragma unroll
        for (int ai = 0; ai < 2; ++ai)
#pragma unroll
            for (int m = 0; m < 4; ++m) { const int r = ai * HALF + wr * 64 + m * 16 + fr;
                const unsigned code = rowt[u.idx * 256 + r]; const float g = gatet[u.idx * 256 + r];
                if (code != 0xFFFFFFFFu) { h16* rowp = yb + ((size_t)(code & 1u) * T + (code >> 1)) * D + col0;
#pragma unroll
                    for (int bj = 0; bj < 2; ++bj) { const f32x4 v0 = acc[ai][bj][m][0] * g, v1 = acc[ai][bj][m][1] * g;
                        u32x4 w; w.x = pkh(v0[0], v0[1]); w.y = pkh(v0[2], v0[3]); w.z = pkh(v1[0], v1[1]); w.w = pkh(v1[2], v1[3]);
                        *(u32x4*)(rowp + bj * HALF) = w; } } }
    }
};
}

#define XB_TMO      128
#define XB_XCNT(j)  (256  + 64 * (j))
#define XB_XSUB(j)  (1280 + 64 * (j))
#define XB_XGEN(j)  (2304 + 64 * (j))
#define XB_TOP      3328
#define XB_TOPGEN   3392
#define XCD_BAR_WORDS 3456
#define XB_SPIN_CAP (1u << 18)
__device__ __forceinline__ unsigned xb_ld(unsigned* p)              { return __hip_atomic_load(p, __ATOMIC_RELAXED, __HIP_MEMORY_SCOPE_AGENT); }
__device__ __forceinline__ unsigned xb_add(unsigned* p, unsigned v) { return __hip_atomic_fetch_add(p, v, __ATOMIC_RELAXED, __HIP_MEMORY_SCOPE_AGENT); }
__device__ __forceinline__ unsigned xb_xcc_id() { return (unsigned)__builtin_amdgcn_s_getreg((3 << 11) | 20) & 0xFu; }
#define XB_SPIN(cond, bar) do { unsigned _sp = 0; while (cond) { __builtin_amdgcn_s_sleep(1); \
    if ((++_sp & 255u) == 0u) { if (xb_ld(&(bar)[XB_TMO])) break; if (_sp > XB_SPIN_CAP) { atomicAdd(&(bar)[XB_TMO], 1u); break; } } } } while (0)
struct XcdBarrier { unsigned* bar; unsigned x; volatile LAS unsigned* st; };
__device__ __forceinline__ XcdBarrier xcd_barrier_post(unsigned* bar, volatile LAS unsigned* st) {
    XcdBarrier b; b.bar = bar; b.x = xb_xcc_id(); b.st = st;
    if (threadIdx.x == 0) (void)xb_add(&bar[XB_XCNT(b.x)], 1u);
    return b;
}
__device__ __forceinline__ void xcd_barrier_complete(unsigned* bar, unsigned x, unsigned& nloc, unsigned& nx) {
    const unsigned G = gridDim.x * gridDim.y * gridDim.z;
    unsigned sum, cnt, mine, sp = 0u;
    for (;;) {
        sum = 0u; cnt = 0u; mine = 0u;
#pragma unroll
        for (unsigned j = 0; j < 16; ++j) { const unsigned c = xb_ld(&bar[XB_XCNT(j)]); sum += c; cnt += (c > 0u) ? 1u : 0u; mine = (j == x) ? c : mine; }
        if (sum == G) break;
        __builtin_amdgcn_s_sleep(1);
        if ((++sp & 255u) == 0u) { if (xb_ld(&bar[XB_TMO])) break; if (sp > XB_SPIN_CAP) { atomicAdd(&bar[XB_TMO], 1u); break; } }
    }
    nloc = mine > 0u ? mine : 1u; nx = cnt > 0u ? cnt : 1u;
}
__device__ __forceinline__ void xcd_barrier(const XcdBarrier& b) {
    asm volatile("s_waitcnt vmcnt(0)" ::: "memory");
    __syncthreads();
    if (threadIdx.x == 0) {
        unsigned* bar = b.bar;
        __builtin_amdgcn_s_waitcnt(0);
        unsigned nloc = b.st[0], nx = b.st[1];
        if (nloc == 0u) { xcd_barrier_complete(bar, b.x, nloc, nx); b.st[0] = nloc; b.st[1] = nx; }
        const unsigned old = xb_add(&bar[XB_XSUB(b.x)], 1u);
        const unsigned gen = old / nloc;
        if (old + 1u == (gen + 1u) * nloc) {
            __builtin_amdgcn_fence(__ATOMIC_RELEASE, "agent");
            asm volatile("s_waitcnt vmcnt(0)" ::: "memory");
            const unsigned og = xb_add(&bar[XB_TOP], 1u);
            const unsigned tg = og / nx;
            if (og + 1u == (tg + 1u) * nx) xb_add(&bar[XB_TOPGEN], 1u);
            else XB_SPIN(xb_ld(&bar[XB_TOPGEN]) == tg, bar);
            __builtin_amdgcn_fence(__ATOMIC_ACQUIRE, "agent");
            xb_add(&bar[XB_XGEN(b.x)], 1u);
            asm volatile("s_waitcnt vmcnt(0)" ::: "memory");
        } else {
            XB_SPIN(xb_ld(&bar[XB_XGEN(b.x)]) == gen, bar);
            __builtin_amdgcn_fence(__ATOMIC_ACQUIRE, "agent");
            asm volatile("s_waitcnt vmcnt(0)" ::: "memory");
        }
    }
    __syncthreads();
}

struct Args { const float* in[22]; float* out; unsigned char* ws; int ph_lo, ph_hi; };
enum { I_X = 0, I_C, I_WADA, I_BADA, I_N1G, I_WIN, I_WOUT, I_WS, I_BS, I_VG, I_CW, I_CB, I_N2G, I_WRG, I_BRG, I_WRE, I_BRE, I_WGU, I_WD, I_WAF, I_BAF, I_NFG };

__device__ __forceinline__ void p0_transpose_item(const float* W, int K, int N, h16* WT, LAS float* scr, int item, int lane, int mode) {
    const int nblk = N / 32, kb = item / nblk, nb = item % nblk, k0 = 64 * kb, n0 = 32 * nb;
#pragma unroll 8
    for (int i = 0; i < 32; ++i) { const int kk = 2 * i + (lane >> 5); scr[kk * 33 + (lane & 31)] = W[(size_t)(k0 + kk) * N + n0 + (lane & 31)]; }
    asm volatile("s_waitcnt lgkmcnt(0)" ::: "memory");
    int r0 = n0;
    if (mode == 1) { const int nn = n0 & 511; r0 = 256 * (nn >> 7) + ((n0 >> 9) << 7) + (nn & 127); }
    const int c = lane & 7;
#pragma unroll
    for (int j = 0; j < 4; ++j) { const int n = (lane >> 3) + 8 * j; const LAS float* s = scr + (8 * c) * 33 + n;
        u32x4 o; o.x = pkh(s[0 * 33], s[1 * 33]); o.y = pkh(s[2 * 33], s[3 * 33]); o.z = pkh(s[4 * 33], s[5 * 33]); o.w = pkh(s[6 * 33], s[7 * 33]);
        *(u32x4*)(WT + (size_t)(r0 + n) * K + k0 + 8 * c) = o; }
    asm volatile("s_waitcnt lgkmcnt(0)" ::: "memory");
}

__global__ void __launch_bounds__(512, 2) mk_fwd(Args args) {
    extern __shared__ __attribute__((aligned(16))) unsigned char lds_raw[];
    LAS unsigned char* lds = (LAS unsigned char*)lds_raw;
    const int tid = threadIdx.x, lane = tid & 63, wave = __builtin_amdgcn_readfirstlane(tid >> 6);
    const int G = gridDim.x, blk = blockIdx.x;
    const int gw = blk * 8 + wave, NGW = G * 8;
    unsigned char* ws = args.ws;
    unsigned* ctl = (unsigned*)(ws + WS_CTL);
    float* mod = (float*)(ws + WS_MOD); float* modf = (float*)(ws + WS_MODF); float* sw = (float*)(ws + WS_SW);
    h16* WrH = (h16*)(ws + WS_WRH); h16* WrL = (h16*)(ws + WS_WRL);
    unsigned* lcode = (unsigned*)(ws + WS_LCODE); float* lgate = (float*)(ws + WS_LGATE);
    h16* Win_t = (h16*)(ws + WS_WIN); h16* Wout_t = (h16*)(ws + WS_WOUT); h16* Wgu_t = (h16*)(ws + WS_WGU); h16* Wd_t = (h16*)(ws + WS_WD);
    h16* hb = (h16*)(ws + WS_H); h16* proj = (h16*)(ws + WS_PROJ); h16* yb = (h16*)(ws + WS_Y); h16* actb = (h16*)(ws + WS_ACT); h16* ybuf = (h16*)(ws + WS_YB); h16* mixg = (h16*)(ws + WS_MIX);
    const float* x = args.in[I_X];

    for (int u = tid; u < (LDS_BYTES - RING_BYTES) / 4; u += 512) ((LAS unsigned*)(lds + RING_BYTES))[u] = 0u;
    __syncthreads();
    XcdBarrier bar; bar.bar = ctl + CW_BAR; bar.x = 0; bar.st = nullptr;
    if (MK_N_LAUNCHES == 1) bar = xcd_barrier_post(ctl + CW_BAR, (volatile LAS unsigned*)(lds + MISC_OFF) + 8);
    const int lo = args.ph_lo, hi = args.ph_hi;
#define IN(k) (lo <= (k) && (k) < hi)
#define SEAM(k) do { if (IN(k) && IN((k) + 1)) { xcd_barrier(bar); if (PROBE_PHASE == 99) xcd_barrier(bar); } } while (0)

    if (IN(0)) _Pragma("unroll") for (int rep_ = 0; rep_ < REPS(0); ++rep_) {
        LAS float* CA = (LAS float*)lds; LAS float* RED = (LAS float*)(lds + 65536);
        const float* c = args.in[I_C];
        __syncthreads();
        for (int idx = tid; idx < NB * D; idx += 512) { const int b = idx >> 11, d = idx & 2047; const float v = c[idx]; CA[d * 8 + b] = v / (1.0f + __expf(-v)); }
        __syncthreads();
        for (int cb = blk; cb < 256; cb += G) {
            const float* W; int N, col0; float* outp; const float* bias;
            if (cb < 192) { W = args.in[I_WADA]; N = NMOD; col0 = cb * 64; outp = mod; bias = args.in[I_BADA]; }
            else { W = args.in[I_WAF]; N = NMODF; col0 = (cb - 192) * 64; outp = modf; bias = args.in[I_BAF]; }
            const int dsub = lane >> 4, cq = lane & 15;
            float acc[8][4];
#pragma unroll
            for (int b = 0; b < 8; ++b)
#pragma unroll
                for (int j = 0; j < 4; ++j) acc[b][j] = 0.f;
            const float* wp = W + (size_t)(wave * 256 + dsub) * N + col0 + 4 * cq;
#pragma unroll 8
            for (int it = 0; it < 64; ++it) {
                const f32x4 wv = *(const f32x4*)(wp + (size_t)it * 4 * N);
                const int d = wave * 256 + it * 4 + dsub;
                const f32x4 c0 = *(const LAS f32x4*)&CA[d * 8], c1 = *(const LAS f32x4*)&CA[d * 8 + 4];
#pragma unroll
                for (int j = 0; j < 4; ++j) {
                    acc[0][j] += c0[0] * wv[j]; acc[1][j] += c0[1] * wv[j]; acc[2][j] += c0[2] * wv[j]; acc[3][j] += c0[3] * wv[j];
                    acc[4][j] += c1[0] * wv[j]; acc[5][j] += c1[1] * wv[j]; acc[6][j] += c1[2] * wv[j]; acc[7][j] += c1[3] * wv[j]; }
            }
#pragma unroll
            for (int b = 0; b < 8; ++b)
#pragma unroll
                for (int j = 0; j < 4; ++j) { float v = acc[b][j]; v += __shfl_xor(v, 16); v += __shfl_xor(v, 32); acc[b][j] = v; }
            if (dsub == 0) {
#pragma unroll
                for (int b = 0; b < 8; ++b) *(LAS f32x4*)&RED[(wave * 8 + b) * 64 + 4 * cq] = (f32x4){acc[b][0], acc[b][1], acc[b][2], acc[b][3]};
            }
            __syncthreads();
            { const int b = tid >> 6, col = tid & 63; float s = bias[col0 + col];
#pragma unroll
              for (int w = 0; w < 8; ++w) s += RED[(w * 8 + b) * 64 + col];
              outp[(size_t)b * N + col0 + col] = s; }
            __syncthreads();
        }
        for (int idx = blk * 512 + tid; idx < NRP * D; idx += G * 512) { const int n = idx >> 11, k = idx & 2047; float w = 0.f;
            if (n < 4) w = args.in[I_WRG][k * 4 + n]; else if (n < 36) w = args.in[I_WRE][k * 32 + (n - 4)];
            w *= 1024.0f; const h16 hi_ = (h16)w; const h16 lo_ = (h16)(w - (float)hi_); WrH[idx] = hi_; WrL[idx] = lo_; }
        LAS float* scr = (LAS float*)(lds + wave * 16384);
        constexpr int I_IN = (D / 64) * (INC / 32), I_OUT = (D / 64) * (D / 32), I_GU1 = (D / 64) * (GU / 32), I_D1 = (DE / 64) * (D / 32);
        constexpr int NITEMS = I_IN + I_OUT + NE * I_GU1 + NE * I_D1;
        for (int it = gw; it < NITEMS; it += NGW) {
            int r = it;
            if (r < I_IN) { p0_transpose_item(args.in[I_WIN], D, INC, Win_t, scr, r, lane, 0); continue; } r -= I_IN;
            if (r < I_OUT) { p0_transpose_item(args.in[I_WOUT], D, D, Wout_t, scr, r, lane, 0); continue; } r -= I_OUT;
            if (r < NE * I_GU1) { const int e = r / I_GU1; p0_transpose_item(args.in[I_WGU] + (size_t)e * D * GU, D, GU, Wgu_t + (size_t)e * GU * D, scr, r % I_GU1, lane, 1); continue; } r -= NE * I_GU1;
            { const int e = r / I_D1; p0_transpose_item(args.in[I_WD] + (size_t)e * DE * D, DE, D, Wd_t + (size_t)e * D * DE, scr, r % I_D1, lane, 0); }
        }
    }
    SEAM(0);

    if (IN(1)) _Pragma("unroll") for (int rep_ = 0; rep_ < REPS(1); ++rep_) {
        const float* g1 = args.in[I_N1G];
        for (int rb = gw; rb < T / 8; rb += NGW) {
            const int b = (rb * 8) >> 11;
            f32x4 ca[8], cs[8];
#pragma unroll
            for (int j = 0; j < 8; ++j) { const int col = 4 * lane + 256 * j; const f32x4 g = *(const f32x4*)(g1 + col), sc = *(const f32x4*)(mod + (size_t)b * NMOD + D + col);
                ca[j] = g * (sc + 1.0f); cs[j] = *(const f32x4*)(mod + (size_t)b * NMOD + col); }
            for (int r = 0; r < 8; ++r) { const int row = rb * 8 + r; const f32x4* xr = (const f32x4*)(x + (size_t)row * D) + lane;
                f32x4 v[8]; float ss = 0.f;
#pragma unroll
                for (int j = 0; j < 8; ++j) { v[j] = xr[64 * j]; ss += (v[j][0] * v[j][0] + v[j][1] * v[j][1]) + (v[j][2] * v[j][2] + v[j][3] * v[j][3]); }
                const float rstd = 1.0f / sqrtf(wave_sum(ss) * (1.0f / D) + EPS);
                u32x2* o = (u32x2*)(hb + (size_t)row * D) + lane;
#pragma unroll
                for (int j = 0; j < 8; ++j) { const f32x4 y = v[j] * rstd * ca[j] + cs[j]; u32x2 w; w.x = pkh(y[0], y[1]); w.y = pkh(y[2], y[3]); o[64 * j] = w; }
            }
        }
        for (int q = gw; q < NB * 36; q += NGW) { const int b = q / 36, j = q % 36; float s = 0.f;
            for (int d = lane; d < D; d += 64) { const float w = (j < 4) ? args.in[I_WRG][d * 4 + j] : args.in[I_WRE][d * 32 + (j - 4)]; s += mod[(size_t)b * NMOD + 3 * D + d] * w; }
            s = wave_sum(s); if (lane == 0) sw[b * NRP + j] = s + ((j < 4) ? args.in[I_BRG][j] : args.in[I_BRE][j - 4]); }
    }
    SEAM(1);

    if (IN(2)) _Pragma("unroll") for (int rep_ = 0; rep_ < REPS(2); ++rep_) {
        pg8::DenseOrder S; S.init(hb, Win_t, T, INC, D, G, blk);
        pg8::EpiInProj E{proj};
        pg8::gemm_phase<pg8::EpiInProj, pg8::DenseOrder, false>(lds, D, S, E, nullptr);
    }
    SEAM(2);

    if (IN(3)) _Pragma("unroll") for (int rep_ = 0; rep_ < REPS(3); ++rep_) {
        LAS h16* WL = (LAS h16*)lds; LAS h16* VT = (LAS h16*)(lds + 34816);
        for (int job = blk; job < 256; job += G) {
            const int hh = job & 7, pg = job >> 3;
            __syncthreads();
            { const int t = tid >> 2, q0 = (tid & 3) * 32; const float* wrow = args.in[I_WS] + ((size_t)hh * 128 + t) * 128 + q0;
#pragma unroll
              for (int i = 0; i < 4; ++i) { const f32x4 a = *(const f32x4*)(wrow + 8 * i), bq = *(const f32x4*)(wrow + 8 * i + 4); const int q = q0 + 8 * i;
                  u32x4 w; w.x = pkh(q + 0 <= t ? a[0] : 0.f, q + 1 <= t ? a[1] : 0.f); w.y = pkh(q + 2 <= t ? a[2] : 0.f, q + 3 <= t ? a[3] : 0.f);
                  w.z = pkh(q + 4 <= t ? bq[0] : 0.f, q + 5 <= t ? bq[1] : 0.f); w.w = pkh(q + 6 <= t ? bq[2] : 0.f, q + 7 <= t ? bq[3] : 0.f);
                  *(LAS u32x4*)(WL + t * 136 + q) = w; } }
            const int q = tid >> 2, d0 = (tid & 3) * 32;
            for (int pi = 0; pi < 4; ++pi) {
                const int pair = pg * 4 + pi, tok0 = (pair >> 4) * SEQ + (pair & 15) * 128;
                { const h16* vrow = proj + (size_t)(tok0 + q) * INC + AW + hh * 128 + d0; const float* gn = args.in[I_VG] + hh * 128 + d0;
                  h16x8 v[4]; float ss = 0.f;
#pragma unroll
                  for (int i = 0; i < 4; ++i) { v[i] = *(const h16x8*)(vrow + 8 * i);
#pragma unroll
                      for (int j = 0; j < 8; ++j) { const float f = (float)v[i][j]; ss += f * f; } }
                  ss += __shfl_xor(ss, 1); ss += __shfl_xor(ss, 2);
                  const float rstd = 1.0f / sqrtf(ss * (1.0f / 128.0f) + EPS);
#pragma unroll
                  for (int i = 0; i < 4; ++i) { const f32x4 g0 = *(const f32x4*)(gn + 8 * i), g1v = *(const f32x4*)(gn + 8 * i + 4);
#pragma unroll
                      for (int j = 0; j < 8; ++j) { const float g = j < 4 ? g0[j & 3] : g1v[j & 3]; VT[(d0 + 8 * i + j) * 136 + q] = (h16)((float)v[i][j] * rstd * g); } } }
                __syncthreads();
                { const int fr = lane & 15, fq = lane >> 4; f32x4 acc[8];
#pragma unroll
                  for (int n = 0; n < 8; ++n) acc[n] = (f32x4){0.f, 0.f, 0.f, 0.f};
                  const int nks = (wave >> 1) + 1;
                  for (int ks = 0; ks < nks; ++ks) { const h16x8 wf = *(const LAS h16x8*)(WL + (16 * wave + fr) * 136 + 32 * ks + 8 * fq);
#pragma unroll
                      for (int n = 0; n < 8; ++n) { const h16x8 vf = *(const LAS h16x8*)(VT + (16 * n + fr) * 136 + 32 * ks + 8 * fq); acc[n] = __builtin_amdgcn_mfma_f32_16x16x32_f16(vf, wf, acc[n], 0, 0, 0); } }
                  const int t = 16 * wave + fr; const float bs = args.in[I_BS][hh * 128 + t];
                  const h16* urow = proj + (size_t)(tok0 + t) * INC + hh * 128 + 4 * fq; h16* yrow = yb + (size_t)(tok0 + t) * D + hh * 128 + 4 * fq;
#pragma unroll
                  for (int n = 0; n < 8; ++n) { const h16x4 uv = *(const h16x4*)(urow + 16 * n);
                      u32x2 w; w.x = pkh((float)uv[0] * (acc[n][0] + bs), (float)uv[1] * (acc[n][1] + bs)); w.y = pkh((float)uv[2] * (acc[n][2] + bs), (float)uv[3] * (acc[n][3] + bs));
                      *(u32x2*)(yrow + 16 * n) = w; } }
                __syncthreads();
            }
        }
        for (int job = blk; job < 256; job += G) {
            const int ch = (tid & 127) * 8, t0 = job * 64 + (tid >> 7) * 16;
            float w0[8], w1[8], w2[8], cbv[8];
#pragma unroll
            for (int j = 0; j < 8; ++j) { w0[j] = args.in[I_CW][ch + j]; w1[j] = args.in[I_CW][1024 + ch + j]; w2[j] = args.in[I_CW][2048 + ch + j]; cbv[j] = args.in[I_CB][ch + j]; }
            float p1[8], p2[8];
            if ((t0 & (SEQ - 1)) == 0) {
#pragma unroll
                for (int j = 0; j < 8; ++j) { p1[j] = 0.f; p2[j] = 0.f; }
            } else {
                const h16x8 c1 = *(const h16x8*)(proj + (size_t)(t0 - 1) * INC + 3072 + ch), x1v = *(const h16x8*)(proj + (size_t)(t0 - 1) * INC + 4096 + ch);
                const h16x8 c2 = *(const h16x8*)(proj + (size_t)(t0 - 2) * INC + 3072 + ch), x2v = *(const h16x8*)(proj + (size_t)(t0 - 2) * INC + 4096 + ch);
#pragma unroll
                for (int j = 0; j < 8; ++j) { p1[j] = (float)c1[j] * (float)x1v[j]; p2[j] = (float)c2[j] * (float)x2v[j]; }
            }
#pragma unroll 4
            for (int i = 0; i < 16; ++i) { const size_t ro = (size_t)(t0 + i) * INC + ch;
                const h16x8 bg = *(const h16x8*)(proj + ro + 2048), cg = *(const h16x8*)(proj + ro + 3072), xi = *(const h16x8*)(proj + ro + 4096);
                float o[8];
#pragma unroll
                for (int j = 0; j < 8; ++j) { const float pre = (float)cg[j] * (float)xi[j]; o[j] = (float)bg[j] * (w0[j] * p2[j] + w1[j] * p1[j] + w2[j] * pre + cbv[j]); p2[j] = p1[j]; p1[j] = pre; }
                u32x4 w; w.x = pkh(o[0], o[1]); w.y = pkh(o[2], o[3]); w.z = pkh(o[4], o[5]); w.w = pkh(o[6], o[7]);
                *(u32x4*)(yb + (size_t)(t0 + i) * D + AW + ch) = w; }
        }
    }
    SEAM(3);

    if (IN(4)) _Pragma("unroll") for (int rep_ = 0; rep_ < REPS(4); ++rep_) {
        pg8::DenseOrder S; S.init(yb, Wout_t, T, D, D, G, blk);
        pg8::EpiOutProj E{mod, mixg};
        pg8::gemm_phase<pg8::EpiOutProj, pg8::DenseOrder, false>(lds, D, S, E, nullptr);
    }
    SEAM(4);

    if (IN(5)) _Pragma("unroll") for (int rep_ = 0; rep_ < REPS(5); ++rep_) {
        const bool dummy_ = (PROBE_PHASE == 5 && rep_ == 0); unsigned* cntp = ctl + CW_CNT + (dummy_ ? 4096 : 0); unsigned* lcode_w = dummy_ ? (unsigned*)(ws + WS_WIN) : lcode; float* lgate_w = dummy_ ? (float*)(ws + WS_WIN + 4 * MiB) : lgate;
        LAS float* GS = (LAS float*)lds; LAS float* SH = (LAS float*)(lds + 8192); LAS float* LG = (LAS float*)(lds + 16384); LAS float* SSP = (LAS float*)(lds + 40960);
        LAS float* LOGIT = (LAS float*)(lds + 41472); LAS float* RSTD = (LAS float*)(lds + 43776);
        LAS int* AE = (LAS int*)(lds + 44032); LAS float* AG = (LAS float*)(lds + 44544); LAS int* HIST = (LAS int*)(lds + 45056); LAS int* BASE = (LAS int*)(lds + 45184);
        const int fr = lane & 15, fq = lane >> 4;
        for (int job = blk; job < 256; job += G) {
            const int b = job >> 5;
            __syncthreads();
            for (int k = tid; k < D; k += 512) { GS[k] = args.in[I_N2G][k] * (1.0f + mod[(size_t)b * NMOD + 4 * D + k]); SH[k] = mod[(size_t)b * NMOD + 3 * D + k]; }
            if (tid < 32) HIST[tid] = 0;
            __syncthreads();
            for (int ti = 0; ti < 4; ++ti) {
                const int tok0 = job * 64 + ti * 16;
                float z[8][8]; f32x4 acc[3]; float ss = 0.f;
#pragma unroll
                for (int n = 0; n < 3; ++n) acc[n] = (f32x4){0.f, 0.f, 0.f, 0.f};
                const float* xrow = x + (size_t)(tok0 + fr) * D + 256 * wave + 8 * fq; const h16* mrow = mixg + (size_t)(tok0 + fr) * D + 256 * wave + 8 * fq;
                const h16* whp = WrH + (size_t)fr * D + 256 * wave + 8 * fq; const h16* wlp = WrL + (size_t)fr * D + 256 * wave + 8 * fq;
#pragma unroll
                for (int s = 0; s < 8; ++s) {
                    f32x4 xa = *(const f32x4*)(xrow + 32 * s), xb = *(const f32x4*)(xrow + 32 * s + 4); { const h16x8 mv = *(const h16x8*)(mrow + 32 * s);
#pragma unroll
                        for (int j = 0; j < 4; ++j) { xa[j] += (float)mv[j]; xb[j] += (float)mv[4 + j]; } }
                    const f32x4 ga = *(const LAS f32x4*)&GS[256 * wave + 32 * s + 8 * fq], gb = *(const LAS f32x4*)&GS[256 * wave + 32 * s + 8 * fq + 4];
                    h16x8 zh, zl;
#pragma unroll
                    for (int j = 0; j < 4; ++j) { z[s][j] = xa[j] * ga[j]; z[s][4 + j] = xb[j] * gb[j]; ss += xa[j] * xa[j] + xb[j] * xb[j]; }
#pragma unroll
                    for (int j = 0; j < 8; ++j) { zh[j] = (h16)z[s][j]; zl[j] = (h16)(z[s][j] - (float)zh[j]); }
#pragma unroll
                    for (int n = 0; n < 3; ++n) { const h16x8 wh = *(const h16x8*)(whp + (size_t)(16 * n) * D + 32 * s), wl = *(const h16x8*)(wlp + (size_t)(16 * n) * D + 32 * s);
                        acc[n] = __builtin_amdgcn_mfma_f32_16x16x32_f16(wh, zh, acc[n], 0, 0, 0);
                        acc[n] = __builtin_amdgcn_mfma_f32_16x16x32_f16(wl, zh, acc[n], 0, 0, 0);
                        acc[n] = __builtin_amdgcn_mfma_f32_16x16x32_f16(wh, zl, acc[n], 0, 0, 0); }
                }
                ss += __shfl_xor(ss, 16); ss += __shfl_xor(ss, 32);
                if (fq == 0) SSP[wave * 16 + fr] = ss;
#pragma unroll
                for (int n = 0; n < 3; ++n) *(LAS f32x4*)&LG[(wave * 16 + fr) * NRP + 16 * n + 4 * fq] = acc[n];
                __syncthreads();
                for (int idx = tid; idx < 16 * 36; idx += 512) { const int tk = idx / 36, j = idx % 36; float sq = 0.f, lg = 0.f;
#pragma unroll
                    for (int w = 0; w < 8; ++w) { sq += SSP[w * 16 + tk]; lg += LG[(w * 16 + tk) * NRP + j]; }
                    const float rstd = 1.0f / sqrtf(sq * (1.0f / D) + EPS);
                    LOGIT[tk * 36 + j] = lg * rstd * (1.0f / 1024.0f) + sw[b * NRP + j]; if (j == 0) RSTD[tk] = rstd; }
                __syncthreads();
                if (tid < 16) {
                    const LAS float* L = LOGIT + tid * 36;
                    int grp = 0; float gm = L[0];
#pragma unroll
                    for (int j = 1; j < 4; ++j) if (L[j] > gm) { gm = L[j]; grp = j; }
                    float den = 0.f;
#pragma unroll
                    for (int j = 0; j < 4; ++j) den += __expf(L[j] - gm);
                    const float pg_ = 1.0f / den;
                    const LAS float* EL = L + 4 + grp * 8;
                    int i1 = 0; float v1 = EL[0];
#pragma unroll
                    for (int j = 1; j < 8; ++j) if (EL[j] > v1) { v1 = EL[j]; i1 = j; }
                    int i2 = -1; float v2 = -3.0e38f;
#pragma unroll
                    for (int j = 0; j < 8; ++j) if (j != i1 && EL[j] > v2) { v2 = EL[j]; i2 = j; }
                    const float e2 = __expf(v2 - v1), g1_ = pg_ / (1.0f + e2), g2_ = pg_ * e2 / (1.0f + e2);
                    const int a = (ti * 16 + tid) * 2;
                    AE[a] = grp * 8 + i1; AG[a] = g1_; AE[a + 1] = grp * 8 + i2; AG[a + 1] = g2_;
                }
                { const float rstd = RSTD[fr]; h16* hrow = hb + (size_t)(tok0 + fr) * D + 256 * wave + 8 * fq;
#pragma unroll
                  for (int s = 0; s < 8; ++s) { const f32x4 sa = *(const LAS f32x4*)&SH[256 * wave + 32 * s + 8 * fq], sb = *(const LAS f32x4*)&SH[256 * wave + 32 * s + 8 * fq + 4];
                      u32x4 w; w.x = pkh(z[s][0] * rstd + sa[0], z[s][1] * rstd + sa[1]); w.y = pkh(z[s][2] * rstd + sa[2], z[s][3] * rstd + sa[3]);
                      w.z = pkh(z[s][4] * rstd + sb[0], z[s][5] * rstd + sb[1]); w.w = pkh(z[s][6] * rstd + sb[2], z[s][7] * rstd + sb[3]);
                      *(u32x4*)(hrow + 32 * s) = w; } }
                __syncthreads();
            }
            int e_ = 0, rank = 0;
            if (tid < 128) { e_ = AE[tid]; __hip_atomic_fetch_add(&HIST[e_], 1, __ATOMIC_RELAXED, __HIP_MEMORY_SCOPE_WORKGROUP); for (int j = 0; j < tid; ++j) rank += (AE[j] == e_) ? 1 : 0; }
            __syncthreads();
            if (tid < 32) { const int hc = HIST[tid]; BASE[tid] = hc > 0 ? (int)__hip_atomic_fetch_add(cntp + 64 * tid, (unsigned)hc, __ATOMIC_RELAXED, __HIP_MEMORY_SCOPE_AGENT) : 0; }
            __syncthreads();
            if (tid < 128) { const int pos = BASE[e_] + rank; lcode_w[(size_t)e_ * T + pos] = (unsigned)((job * 64 + (tid >> 1)) * 2 + (tid & 1)); lgate_w[(size_t)e_ * T + pos] = AG[tid]; }
        }
    }
    SEAM(5);

    if (IN(6) || IN(7)) {
        LAS int* TAB = (LAS int*)(lds + TAB_OFF); LAS unsigned* ROWT = (LAS unsigned*)(lds + ROWT_OFF); LAS float* GATET = (LAS float*)(lds + GATET_OFF);
        __syncthreads();
        if (tid < 32) TAB[tid] = (int)__hip_atomic_load(ctl + CW_CNT + 64 * tid, __ATOMIC_RELAXED, __HIP_MEMORY_SCOPE_AGENT);
        __syncthreads();
        if (tid == 0) { int s = 0; for (int e = 0; e < NE; ++e) { TAB[32 + e] = s; s += (TAB[e] + 255) >> 8; } TAB[64] = s; }
        __syncthreads();
        const int TT = TAB[64];
        if (IN(6)) _Pragma("unroll") for (int rep_ = 0; rep_ < REPS(6); ++rep_) {
            pg8::MoeOrder S; S.A = (const char*)hb; S.Bt = (const char*)Wgu_t; S.a_tile = 0; S.b_exp = (size_t)GU * D * 2; S.b_pn = (size_t)256 * D * 2; S.NT = 4; S.nwg = TT * 4; S.G = G; S.c = blk; S.tab = TAB;
            for (int i = 0; i < MAXU; ++i) { pg8::Unit u; if (!S.next(i, u)) break;
                if (tid < 256) { const int pos = (u.pm - TAB[32 + u.e]) * 256 + tid; const bool ok = pos < TAB[u.e]; ROWT[i * 256 + tid] = ok ? lcode[(size_t)u.e * T + pos] : 0xFFFFFFFFu; } }
            __syncthreads();
            pg8::EpiUp E{actb};
            pg8::gemm_phase<pg8::EpiUp, pg8::MoeOrder, true>(lds, D, S, E, ROWT);
        }
        SEAM(6);
        if (IN(7)) _Pragma("unroll") for (int rep_ = 0; rep_ < REPS(7); ++rep_) {
            pg8::MoeOrder S; S.A = (const char*)actb; S.Bt = (const char*)Wd_t; S.a_tile = (size_t)256 * DE * 2; S.b_exp = (size_t)D * DE * 2; S.b_pn = (size_t)256 * DE * 2; S.NT = 8; S.nwg = TT * 8; S.G = G; S.c = blk; S.tab = TAB;
            __syncthreads();
            for (int i = 0; i < MAXU; ++i) { pg8::Unit u; if (!S.next(i, u)) break;
                if (tid < 256) { const int pos = (u.pm - TAB[32 + u.e]) * 256 + tid; const bool ok = pos < TAB[u.e];
                    ROWT[i * 256 + tid] = ok ? lcode[(size_t)u.e * T + pos] : 0xFFFFFFFFu; GATET[i * 256 + tid] = ok ? lgate[(size_t)u.e * T + pos] : 0.f; } }
            __syncthreads();
            pg8::EpiDown E{ybuf, ROWT, GATET};
            pg8::gemm_phase<pg8::EpiDown, pg8::MoeOrder, false>(lds, DE, S, E, nullptr);
        }
    }
    SEAM(7);

    if (IN(8)) _Pragma("unroll") for (int rep_ = 0; rep_ < REPS(8); ++rep_) {
        float* outp_ = (PROBE_PHASE == 8 && rep_ == 0) ? (float*)(ws + WS_WGU) : args.out;
        const float* gf = args.in[I_NFG];
        for (int rb = gw; rb < T / 8; rb += NGW) {
            const int b = (rb * 8) >> 11;
            f32x4 cg2[8], ca[8], cs[8];
#pragma unroll
            for (int j = 0; j < 8; ++j) { const int col = 4 * lane + 256 * j; cg2[j] = *(const f32x4*)(mod + (size_t)b * NMOD + 5 * D + col);
                ca[j] = *(const f32x4*)(gf + col) * (*(const f32x4*)(modf + (size_t)b * NMODF + D + col) + 1.0f); cs[j] = *(const f32x4*)(modf + (size_t)b * NMODF + col); }
            for (int r = 0; r < 8; ++r) { const int row = rb * 8 + r; const f32x4* xr = (const f32x4*)(x + (size_t)row * D) + lane; const h16x4* mr = (const h16x4*)(mixg + (size_t)row * D) + lane;
                const h16x4* y0 = (const h16x4*)(ybuf + (size_t)row * D) + lane; const h16x4* y1 = (const h16x4*)(ybuf + ((size_t)T + row) * D) + lane;
                f32x4 v[8]; float ss = 0.f;
#pragma unroll
                for (int j = 0; j < 8; ++j) { f32x4 xv = xr[64 * j]; const h16x4 a = y0[64 * j], c2 = y1[64 * j], mv = mr[64 * j]; xv += (f32x4){(float)mv[0], (float)mv[1], (float)mv[2], (float)mv[3]};
                    const f32x4 f = {(float)a[0] + (float)c2[0], (float)a[1] + (float)c2[1], (float)a[2] + (float)c2[2], (float)a[3] + (float)c2[3]};
                    v[j] = xv + cg2[j] * f; ss += (v[j][0] * v[j][0] + v[j][1] * v[j][1]) + (v[j][2] * v[j][2] + v[j][3] * v[j][3]); }
                const float rstd = 1.0f / sqrtf(wave_sum(ss) * (1.0f / D) + EPS);
                f32x4* o = (f32x4*)(outp_ + (size_t)row * D) + lane;
#pragma unroll
                for (int j = 0; j < 8; ++j) o[64 * j] = v[j] * rstd * ca[j] + cs[j];
            }
        }
    }
#undef IN
#undef SEAM
}

extern "C" void kernel_launch(void* const* d_in, const int* in_sizes, int n_in, void* d_out, int out_size, void* d_ws, size_t ws_size, hipStream_t stream) {
    static int grid = 0;
    if (grid == 0) {
        if (n_in != 22 || in_sizes[0] != T * D || out_size != T * D || ws_size < WS_END) { fprintf(stderr, "kernel_launch: unexpected shapes (n_in %d, in0 %d, out %d, ws %zu); nothing launched\n", n_in, n_in > 0 ? in_sizes[0] : -1, out_size, ws_size); grid = -1; return; }
        int dev = 0, cus = 0, per_cu = 0;
        if (hipGetDevice(&dev) != hipSuccess || hipDeviceGetAttribute(&cus, hipDeviceAttributeMultiprocessorCount, dev) != hipSuccess) { grid = -1; return; }
        if (hipFuncSetAttribute((const void*)mk_fwd, hipFuncAttributeMaxDynamicSharedMemorySize, LDS_BYTES) != hipSuccess) { fprintf(stderr, "kernel_launch: hipFuncSetAttribute failed\n"); grid = -1; return; }
        if (hipOccupancyMaxActiveBlocksPerMultiprocessor(&per_cu, (const void*)mk_fwd, 512, LDS_BYTES) != hipSuccess || per_cu < 1) fprintf(stderr, "kernel_launch: occupancy query reports %d\n", per_cu);
        (void)hipGetLastError();
        grid = cus;
        if (grid > 256) grid = 256;
    }
    if (grid < 0) return;
    if (hipMemsetAsync((char*)d_ws + WS_CTL, 0, CTL_ZERO_BYTES, stream) != hipSuccess) { fprintf(stderr, "kernel_launch: memset failed\n"); return; }
    Args a{};
    for (int i = 0; i < 22; ++i) a.in[i] = (const float*)d_in[i];
    a.out = (float*)d_out; a.ws = (unsigned char*)d_ws;
    if (MK_N_LAUNCHES == 1) { a.ph_lo = 0; a.ph_hi = NPHASE; hipLaunchKernelGGL(mk_fwd, dim3(grid), dim3(512), LDS_BYTES, stream, a); }
    else for (int p = 0; p < NPHASE; ++p) { a.ph_lo = p; a.ph_hi = p + 1; hipLaunchKernelGGL(mk_fwd, dim3(grid), dim3(512), LDS_BYTES, stream, a); }
    const hipError_t le = hipPeekAtLastError();
    if (le != hipSuccess) fprintf(stderr, "kernel_launch: launch failed: %s\n", hipGetErrorName(le));
}
```
